# Optimizing an MI355X kernel written in HIP

```python
import jax, jax.numpy as jnp
from jax import lax
import numpy as np

D_MODEL = 2048
BATCH = 2
SEQ = 8192
DEPTH = 1

MEM_LEN = 256
ROPE_THETA = 10000.0
RMS_EPS = 1e-6
GN_EPS = 1e-5
DIL_GROUPS = ((128, 1), (512, 4), (2048, 16))
N_DIL_GROUPS = len(DIL_GROUPS)
DIL_HEADS = 8
DIL_HEAD_DIM = 128
DIL_WIDTH = DIL_HEADS * DIL_HEAD_DIM
BLK = 128
RET_HEADS = 8
RET_QK_DIM = 128
RET_V_DIM = 256
RET_QK_WIDTH = RET_HEADS * RET_QK_DIM
RET_V_WIDTH = RET_HEADS * RET_V_DIM
RET_CHUNK = 128
XATTN_HEADS = 4
XATTN_HEAD_DIM = D_MODEL // XATTN_HEADS
D_FF = ((8 * D_MODEL // 3 + 255) // 256) * 256
N_BRANCHES = 2
DIL_IN_WIDTH = 3 * N_DIL_GROUPS * DIL_WIDTH
RET_IN_WIDTH = 2 * RET_QK_WIDTH + 2 * RET_V_WIDTH
MIX_IN_WIDTH = DIL_IN_WIDTH + RET_IN_WIDTH + N_BRANCHES * D_MODEL

kernel_name = "hybrid_dilated_retention_gated_block"


def rmsnorm(x, gain):
    xf = x.astype(jnp.float32)
    y = xf * lax.rsqrt(jnp.mean(xf * xf, axis=-1, keepdims=True) + RMS_EPS)
    return (y * gain.astype(jnp.float32)).astype(x.dtype)


def rope(x, pos):
    half = x.shape[-1] // 2
    inv = ROPE_THETA ** (-jnp.arange(half, dtype=jnp.float32) / half)
    ang = pos.astype(jnp.float32)[..., None] * inv
    cos = jnp.cos(ang)[:, :, None, :]
    sin = jnp.sin(ang)[:, :, None, :]
    xf = x.astype(jnp.float32)
    x1, x2 = xf[..., :half], xf[..., half:]
    return jnp.concatenate([x1 * cos - x2 * sin, x2 * cos + x1 * sin], axis=-1).astype(x.dtype)


def swiglu(u, w_in, w_out):
    gate, up = jnp.split(u @ w_in, 2, axis=-1)
    return (jax.nn.silu(gate) * up) @ w_out


def dilated_window_attention(q, k, v, dilation, steps):
    B, S, H, Dh = q.shape
    M = -(-S // (dilation * BLK)) * BLK
    pad = M * dilation - S
    nb = M // BLK

    def to_blocks(t):
        t = jnp.pad(t, ((0, 0), (0, pad), (0, 0), (0, 0)))
        t = t.reshape(B, M, dilation, H, Dh).transpose(0, 2, 1, 3, 4)
        return t.reshape(B * dilation, nb, BLK, H, Dh)

    def with_prev(t):
        prev = jnp.pad(t[:, :-1], ((0, 0), (1, 0), (0, 0), (0, 0), (0, 0)))
        return jnp.concatenate([prev, t], axis=2)

    qb = to_blocks(q)
    kk = with_prev(to_blocks(k))
    vv = with_prev(to_blocks(v))
    s = jnp.einsum('znqhd,znkhd->znhqk', qb, kk).astype(jnp.float32) * (Dh ** -0.5)
    dist = (jnp.arange(BLK)[:, None] + BLK) - jnp.arange(2 * BLK)[None, :]
    band = (dist >= 0) & (dist <= steps)
    has_prev = (jnp.arange(nb)[:, None, None] > 0) | (jnp.arange(2 * BLK)[None, None, :] >= BLK)
    mask = band[None] & has_prev
    s = jnp.where(mask[None, :, None], s, -1e30)
    lse = jax.nn.logsumexp(s, axis=-1)
    p = jnp.exp(s - lse[..., None])
    o = jnp.einsum('znhqk,znkhd->znqhd', p.astype(v.dtype), vv)
    o = o.reshape(B, dilation, M, H, Dh).transpose(0, 2, 1, 3, 4).reshape(B, M * dilation, H, Dh)[:, :S]
    lse = lse.transpose(0, 1, 3, 2).reshape(B, dilation, M, H).transpose(0, 2, 1, 3)
    lse = lse.reshape(B, M * dilation, H)[:, :S]
    return o, lse


def retention(q, k, v, pos):
    B, S, H, dk = q.shape
    dv = v.shape[-1]
    C = RET_CHUNK
    n = S // C
    q = rope(q, pos)
    k = rope(k, pos)
    log_g = jnp.log1p(-jnp.exp2(-5.0 - jnp.arange(H, dtype=jnp.float32)))
    idx = jnp.arange(C, dtype=jnp.float32)
    rel = idx[:, None] - idx[None, :]
    decay_mask = jnp.where(rel >= 0, jnp.exp(jnp.maximum(rel, 0.0)[None] * log_g[:, None, None]), 0.0)
    qc = q.astype(jnp.float32).reshape(B, n, C, H, dk)
    kc = (k.astype(jnp.float32) * (dk ** -0.5)).reshape(B, n, C, H, dk)
    vc = v.astype(jnp.float32).reshape(B, n, C, H, dv)
    scores = jnp.einsum('bnihk,bnjhk->bnhij', qc, kc) * decay_mask[None, None]
    o_inner = jnp.einsum('bnhij,bnjhv->bnihv', scores, vc)
    k_decay = jnp.exp((C - 1 - idx)[:, None] * log_g[None, :])
    kv = jnp.einsum('bnjhk,bnjhv->nbhkv', kc * k_decay[:, :, None], vc)
    chunk_decay = jnp.exp(C * log_g)[None, :, None, None]

    def step(state, kv_n):
        return chunk_decay * state + kv_n, state

    _, prev = lax.scan(step, jnp.zeros((B, H, dk, dv), jnp.float32), kv)
    q_decay = jnp.exp((idx + 1.0)[:, None] * log_g[None, :])
    o_cross = jnp.einsum('bnihk,nbhkv->bnihv', qc * q_decay[:, :, None], prev)
    o = (o_inner + o_cross).reshape(B, S, H, dv)
    mu = jnp.mean(o, axis=-1, keepdims=True)
    var = jnp.mean(jnp.square(o - mu), axis=-1, keepdims=True)
    return (o - mu) * lax.rsqrt(var + GN_EPS)


def hybrid_mixer(u, pos, w_mix_in, w_attn_branch, w_ret_branch, w_mix_out):
    B, S, _ = u.shape
    proj = u @ w_mix_in
    o1 = DIL_IN_WIDTH
    o2 = o1 + RET_QK_WIDTH
    o3 = o2 + RET_QK_WIDTH
    o4 = o3 + RET_V_WIDTH
    o5 = o4 + RET_V_WIDTH
    dil = proj[..., :o1].reshape(B, S, N_DIL_GROUPS, 3, DIL_HEADS, DIL_HEAD_DIM)
    rq = proj[..., o1:o2].reshape(B, S, RET_HEADS, RET_QK_DIM)
    rk = proj[..., o2:o3].reshape(B, S, RET_HEADS, RET_QK_DIM)
    rv = proj[..., o3:o4].reshape(B, S, RET_HEADS, RET_V_DIM)
    rg = proj[..., o4:o5]
    gate_a = proj[..., o5:o5 + D_MODEL]
    gate_b = proj[..., o5 + D_MODEL:]

    qa = rope(dil[:, :, :, 0].reshape(B, S, N_DIL_GROUPS * DIL_HEADS, DIL_HEAD_DIM), pos)
    ka = rope(dil[:, :, :, 1].reshape(B, S, N_DIL_GROUPS * DIL_HEADS, DIL_HEAD_DIM), pos)
    qa = qa.reshape(B, S, N_DIL_GROUPS, DIL_HEADS, DIL_HEAD_DIM)
    ka = ka.reshape(B, S, N_DIL_GROUPS, DIL_HEADS, DIL_HEAD_DIM)
    outs, lses = [], []
    for g, (window, dilation) in enumerate(DIL_GROUPS):
        o, l = dilated_window_attention(qa[:, :, g], ka[:, :, g], dil[:, :, g, 2], dilation, window // dilation)
        outs.append(o)
        lses.append(l)
    alpha = jax.nn.softmax(jnp.stack(lses, axis=0), axis=0)
    attn = jnp.sum(alpha[..., None] * jnp.stack(outs, axis=0).astype(jnp.float32), axis=0)
    attn = attn.reshape(B, S, DIL_WIDTH).astype(u.dtype)

    ret = retention(rq, rk, rv, pos).reshape(B, S, RET_V_WIDTH)
    ret = (jax.nn.silu(rg.astype(jnp.float32)) * ret).astype(u.dtype)

    merged = jax.nn.sigmoid(gate_a) * (attn @ w_attn_branch) + jax.nn.sigmoid(gate_b) * (ret @ w_ret_branch)
    return merged @ w_mix_out


def memory_cross_attention(u, mem_n, wq, wkv, wo):
    B, S, _ = u.shape
    L = mem_n.shape[1]
    q = (u @ wq).reshape(B, S, XATTN_HEADS, XATTN_HEAD_DIM)
    kv = (mem_n @ wkv).reshape(B, L, 2, XATTN_HEADS, XATTN_HEAD_DIM)
    k, v = kv[:, :, 0], kv[:, :, 1]
    s = jnp.einsum('bshd,blhd->bhsl', q, k).astype(jnp.float32) * (XATTN_HEAD_DIM ** -0.5)
    p = jax.nn.softmax(s, axis=-1)
    o = jnp.einsum('bhsl,blhd->bshd', p.astype(u.dtype), v).reshape(B, S, D_MODEL)
    return o @ wo


def setup_inputs(seed: int = 0) -> dict:
    key = jax.random.key(seed)
    ks = iter(jax.random.split(key, 32))

    def w(shape, fan_in):
        return jax.random.normal(next(ks), shape, jnp.float32) * (fan_in ** -0.5)

    def gain(shape):
        return 1.0 + 0.02 * jax.random.normal(next(ks), shape, jnp.float32)

    x = jax.random.normal(next(ks), (BATCH, SEQ, D_MODEL), jnp.float32)
    mem = jax.random.normal(next(ks), (BATCH, MEM_LEN, D_MODEL), jnp.float32)
    offset = jax.random.randint(next(ks), (BATCH, 1), 0, 1024, jnp.int32)
    positions = (offset + jnp.arange(SEQ, dtype=jnp.int32)[None, :]).astype(jnp.int32)
    return {
        "x": x,
        "mem": mem,
        "positions": positions,
        "ffn1_norm": gain((DEPTH, D_MODEL)),
        "ffn1_w_in": w((DEPTH, D_MODEL, 2 * D_FF), D_MODEL),
        "ffn1_w_out": w((DEPTH, D_FF, D_MODEL), D_FF),
        "mix_norm": gain((DEPTH, D_MODEL)),
        "w_mix_in": w((DEPTH, D_MODEL, MIX_IN_WIDTH), D_MODEL),
        "w_attn_branch": w((DEPTH, DIL_WIDTH, D_MODEL), DIL_WIDTH),
        "w_ret_branch": w((DEPTH, RET_V_WIDTH, D_MODEL), RET_V_WIDTH),
        "w_mix_out": w((DEPTH, D_MODEL, D_MODEL), D_MODEL),
        "xattn_norm": gain((DEPTH, D_MODEL)),
        "mem_norm": gain((DEPTH, D_MODEL)),
        "xattn_wq": w((DEPTH, D_MODEL, D_MODEL), D_MODEL),
        "xattn_wkv": w((DEPTH, D_MODEL, 2 * D_MODEL), D_MODEL),
        "xattn_wo": w((DEPTH, D_MODEL, D_MODEL), D_MODEL),
        "ffn2_norm": gain((DEPTH, D_MODEL)),
        "ffn2_w_in": w((DEPTH, D_MODEL, 2 * D_FF), D_MODEL),
        "ffn2_w_out": w((DEPTH, D_FF, D_MODEL), D_FF),
        "final_norm": gain((D_MODEL,)),
    }


def reference(x, mem, positions, ffn1_norm, ffn1_w_in, ffn1_w_out, mix_norm, w_mix_in,
              w_attn_branch, w_ret_branch, w_mix_out, xattn_norm, mem_norm, xattn_wq,
              xattn_wkv, xattn_wo, ffn2_norm, ffn2_w_in, ffn2_w_out, final_norm):
    h = x
    for l in range(DEPTH):
        h = h + 0.5 * swiglu(rmsnorm(h, ffn1_norm[l]), ffn1_w_in[l], ffn1_w_out[l])
        h = h + hybrid_mixer(rmsnorm(h, mix_norm[l]), positions, w_mix_in[l],
                             w_attn_branch[l], w_ret_branch[l], w_mix_out[l])
        h = h + memory_cross_attention(rmsnorm(h, xattn_norm[l]), rmsnorm(mem, mem_norm[l]),
                                       xattn_wq[l], xattn_wkv[l], xattn_wo[l])
        h = h + 0.5 * swiglu(rmsnorm(h, ffn2_norm[l]), ffn2_w_in[l], ffn2_w_out[l])
    return rmsnorm(h, final_norm)
```

```cpp
#include <hip/hip_runtime.h>
#include <hip/hip_cooperative_groups.h>
#include <cstdio>
namespace cg = cooperative_groups;

#ifndef ONE_LAUNCH
#define ONE_LAUNCH 1
#endif

#define LAS __attribute__((address_space(3)))
typedef unsigned short bf16_t;
typedef short bf16x8 __attribute__((ext_vector_type(8)));
typedef short s16x4 __attribute__((ext_vector_type(4)));
typedef float f32x4 __attribute__((ext_vector_type(4)));
typedef float f32x2 __attribute__((ext_vector_type(2)));
typedef unsigned u32x4 __attribute__((ext_vector_type(4)));
typedef unsigned u32x2 __attribute__((ext_vector_type(2)));
typedef __bf16 bf16x2_t __attribute__((ext_vector_type(2)));

constexpr int T_TOK = 16384, DM = 2048, SEQ = 8192, DFF = 5632, NP1 = 15360;
constexpr long MIB = 1048576;
constexpr long R0 = 0, R1 = 503316480, R2 = R1 + 67108864, WS_END = R2 + 100663296;
constexpr int RQ0 = 9216, RK0 = 10240, RV0 = 11264, RG0 = 13312;
constexpr int GA0 = 1024, GB0 = 4096, MG0 = 7168;
constexpr float LOG2E = 1.4426950408889634f;
constexpr int LDS_BYTES = 143376;
constexpr long CTL0 = WS_END;
constexpr long CTL_BAR_BYTES = 16384;
constexpr long CTL_BYTES = CTL_BAR_BYTES + 3 * 65536;
constexpr long SS0_OFF = CTL0 + CTL_BYTES;
constexpr long MEMN_OFF = CTL0 + 1 * MIB, KX_OFF = MEMN_OFF + 2 * MIB, VT_OFF = KX_OFF + 2 * MIB, WS_NEED = VT_OFF + 2 * MIB;

struct Params {
    const float* in[20];
    float* out; unsigned char* ws;
    int lo, hi;
};

__device__ __forceinline__ unsigned pk2(float a, float b) { f32x2 v = {a, b}; return __builtin_bit_cast(unsigned, __builtin_convertvector(v, bf16x2_t)); }
__device__ __forceinline__ float bflo(unsigned w) { return __uint_as_float(w << 16); }
__device__ __forceinline__ float bfhi(unsigned w) { return __uint_as_float(w & 0xffff0000u); }
__device__ __forceinline__ float silu_f(float x) { return x * __builtin_amdgcn_rcpf(1.f + __builtin_amdgcn_exp2f(-LOG2E * x)); }
__device__ __forceinline__ float sigm_f(float x) { return __builtin_amdgcn_rcpf(1.f + __builtin_amdgcn_exp2f(-LOG2E * x)); }
__device__ __forceinline__ u32x4 pk8(const f32x4 a, const f32x4 b) { u32x4 w; w.x = pk2(a[0], a[1]); w.y = pk2(a[2], a[3]); w.z = pk2(b[0], b[1]); w.w = pk2(b[2], b[3]); return w; }
__device__ __forceinline__ float wave_sum(float v) { for (int o = 32; o >= 1; o >>= 1) v += __shfl_xor(v, o); return v; }
__device__ __forceinline__ float wave_max(float v) { for (int o = 32; o >= 1; o >>= 1) v = fmaxf(v, __shfl_xor(v, o)); return v; }
__device__ __forceinline__ bf16x8 tr2(LAS unsigned char* p0, LAS unsigned char* p1) {
    s16x4 a = __builtin_amdgcn_ds_read_tr16_b64_v4i16((LAS s16x4*)p0);
    s16x4 b = __builtin_amdgcn_ds_read_tr16_b64_v4i16((LAS s16x4*)p1);
    return __builtin_shufflevector(a, b, 0, 1, 2, 3, 4, 5, 6, 7);
}
__device__ __forceinline__ int otid() { int t = threadIdx.x; asm volatile("" : "+v"(t)); return t; }
#define XB_TMO      128
#define XB_XCNT(j)  (256  + 64 * (j))
#define XB_XSUB(j)  (1280 + 64 * (j))
#define XB_XGEN(j)  (2304 + 64 * (j))
#define XB_TOP      3328
#define XB_TOPGEN   3392
#define XB_SPIN_CAP (1u << 20)
__device__ __forceinline__ unsigned xb_ld(unsigned* p)              { return __hip_atomic_load(p, __ATOMIC_RELAXED, __HIP_MEMORY_SCOPE_AGENT); }
__device__ __forceinline__ unsigned xb_add(unsigned* p, unsigned v) { return __hip_atomic_fetch_add(p, v, __ATOMIC_RELAXED, __HIP_MEMORY_SCOPE_AGENT); }
__device__ __forceinline__ unsigned xb_xcc_id() { return (unsigned)__builtin_amdgcn_s_getreg((3 << 11) | 20) & 0xFu; }
#define XB_SPIN(cond, bar) do { unsigned _sp = 0; while (cond) { __builtin_amdgcn_s_sleep(1); \
    if ((++_sp & 255u) == 0u) { if (xb_ld(&(bar)[XB_TMO])) break; if (_sp > XB_SPIN_CAP) { atomicAdd(&(bar)[XB_TMO], 1u); break; } } } } while (0)
struct XcdBarrier { unsigned* bar; unsigned x; volatile LAS unsigned* st; };
__device__ __forceinline__ XcdBarrier xcd_barrier_post(unsigned* bar, volatile LAS unsigned* st) {
    XcdBarrier b; b.bar = bar; b.x = xb_xcc_id(); b.st = st;
    if (threadIdx.x == 0) (void)xb_add(&bar[XB_XCNT(b.x)], 1u);
    return b;
}
__device__ __forceinline__ void xcd_barrier_complete(unsigned* bar, unsigned x, unsigned& nloc, unsigned& nx) {
    const unsigned G = gridDim.x * gridDim.y * gridDim.z;
    unsigned sum, cnt, mine, sp = 0u;
    for (;;) {
        sum = 0u; cnt = 0u; mine = 0u;
        unsigned cv[16];
        { unsigned* cbase = &bar[XB_XCNT(0)];
          asm volatile("global_load_dword %0, %16, off sc1\n\t"
            "global_load_dword %1, %16, off offset:256 sc1\n\t"
            "global_load_dword %2, %16, off offset:512 sc1\n\t"
            "global_load_dword %3, %16, off offset:768 sc1\n\t"
            "global_load_dword %4, %16, off offset:1024 sc1\n\t"
            "global_load_dword %5, %16, off offset:1280 sc1\n\t"
            "global_load_dword %6, %16, off offset:1536 sc1\n\t"
            "global_load_dword %7, %16, off offset:1792 sc1\n\t"
            "global_load_dword %8, %16, off offset:2048 sc1\n\t"
            "global_load_dword %9, %16, off offset:2304 sc1\n\t"
            "global_load_dword %10, %16, off offset:2560 sc1\n\t"
            "global_load_dword %11, %16, off offset:2816 sc1\n\t"
            "global_load_dword %12, %16, off offset:3072 sc1\n\t"
            "global_load_dword %13, %16, off offset:3328 sc1\n\t"
            "global_load_dword %14, %16, off offset:3584 sc1\n\t"
            "global_load_dword %15, %16, off offset:3840 sc1\n\t"
            "s_waitcnt vmcnt(0)"
            : "=&v"(cv[0]), "=&v"(cv[1]), "=&v"(cv[2]), "=&v"(cv[3]), "=&v"(cv[4]), "=&v"(cv[5]), "=&v"(cv[6]), "=&v"(cv[7]), "=&v"(cv[8]), "=&v"(cv[9]), "=&v"(cv[10]), "=&v"(cv[11]), "=&v"(cv[12]), "=&v"(cv[13]), "=&v"(cv[14]), "=&v"(cv[15]) : "v"(cbase) : "memory"); }
#pragma unroll
        for (unsigned j = 0; j < 16; ++j) { const unsigned c = cv[j]; sum += c; cnt += (c > 0u) ? 1u : 0u; mine = (j == x) ? c : mine; }
        if (sum == G) break;
        __builtin_amdgcn_s_sleep(1);
        if ((++sp & 255u) == 0u) { if (xb_ld(&bar[XB_TMO])) break; if (sp > XB_SPIN_CAP) { atomicAdd(&bar[XB_TMO], 1u); break; } }
    }
    nloc = mine > 0u ? mine : 1u; nx = cnt > 0u ? cnt : 1u;
}
__device__ __forceinline__ void xcd_barrier(const XcdBarrier& b) {
    asm volatile("s_waitcnt vmcnt(0)" ::: "memory");
    __syncthreads();
    if (threadIdx.x == 0) {
        unsigned* bar = b.bar;
        __builtin_amdgcn_s_waitcnt(0);
        unsigned nloc = b.st[0], nx = b.st[1];
        if (nloc == 0u) { xcd_barrier_complete(bar, b.x, nloc, nx); b.st[0] = nloc; b.st[1] = nx; }
        const unsigned old = xb_add(&bar[XB_XSUB(b.x)], 1u);
        const unsigned gen = old / nloc;
        if (old + 1u == (gen + 1u) * nloc) {
            __builtin_amdgcn_fence(__ATOMIC_RELEASE, "agent");
            asm volatile("s_waitcnt vmcnt(0)" ::: "memory");
            const unsigned og = xb_add(&bar[XB_TOP], 1u);
            const unsigned tg = og / nx;
            if (og + 1u == (tg + 1u) * nx) xb_add(&bar[XB_TOPGEN], 1u);
            else XB_SPIN(xb_ld(&bar[XB_TOPGEN]) == tg, bar);
            __builtin_amdgcn_fence(__ATOMIC_ACQUIRE, "agent");
            xb_add(&bar[XB_XGEN(b.x)], 1u);
            asm volatile("s_waitcnt vmcnt(0)" ::: "memory");
        } else {
            XB_SPIN(xb_ld(&bar[XB_XGEN(b.x)]) == gen, bar);
            __builtin_amdgcn_fence(__ATOMIC_ACQUIRE, "agent");
            asm volatile("s_waitcnt vmcnt(0)" ::: "memory");
        }
    }
    __syncthreads();
}
__device__ __forceinline__ u32x4 widen16(u32x2 a, u32x2 b) {
    const auto r0 = __builtin_amdgcn_permlane16_swap(a.x, b.x, false, false);
    const auto r1 = __builtin_amdgcn_permlane16_swap(a.y, b.y, false, false);
    return (u32x4){r0[0], r1[0], r0[1], r1[1]};
}
#define MFMA16(a, b, c) __builtin_amdgcn_mfma_f32_16x16x32_bf16((a), (b), (c), 0, 0, 0)

struct Pre { float v[2]; };
__device__ __forceinline__ Pre pre_rows(const float* ss, int rowbase) { Pre p; p.v[0] = 1.0f; p.v[1] = 1.0f;
    if (ss) { const float* q = ss + rowbase;
        asm volatile("global_load_dword %0, %2, off\n\tglobal_load_dword %1, %2, off offset:512" : "=&v"(p.v[0]), "=&v"(p.v[1]) : "v"(q) : "memory"); }
    return p; }
__device__ __forceinline__ float pre_get(const Pre& p, int ai, int m, int fr) { return __shfl(p.v[ai], m * 16 + fr); }
__device__ __forceinline__ float rstd_pre(const float* ss, float v) { return ss ? rsqrtf(v * (1.0f / 2048.0f) + 1e-6f) : 1.0f; }
namespace pg8 {
constexpr int BM = 256, BK = 64, HALF = 128, HTB = HALF * BK * 2, NXCD = 8;
__device__ __forceinline__ int lds_byte(int r, int c) { const int st = (r >> 4) * 2 + (c >> 5), rr = r & 15, cc = c & 31, ob = rr * 64 + cc * 2; return st * 1024 + (ob ^ (((ob >> 9) & 1) << 5)); }
__device__ __forceinline__ void stage_rc(int b, int& R, int& C) { const int st = b / 1024, sb = b % 1024, swz = sb ^ (((sb >> 9) & 1) << 5); R = (st >> 1) * 16 + swz / 64; C = (st & 1) * 32 + (swz % 64) / 2; }
__device__ __forceinline__ int perm32(int rho) { const int n = rho >> 4, i = rho & 15; return 8 * (i >> 2) + 4 * n + (i & 3); }

struct Unit { int pm, pn, zb, zh; long ao, bo; };
struct Gemm { const bf16_t* A; const bf16_t* Bt; int K, lda, ldb; };
struct Sched {
    int nM, nN, per, total, G, c, nh, WGM; long tA, tB, sAb, sAh, sBb, sBh;
    __device__ __forceinline__ bool next(int i, Unit& u) const {
        const long L = (long)i * G + c; if (L >= total) return false;
        const int z = (int)(L / per); int wgid = (int)(L % per);
        { const int q = per / NXCD, r = per % NXCD, xcd = wgid % NXCD, off = wgid / NXCD; wgid = (xcd < r ? xcd * (q + 1) : r * (q + 1) + (xcd - r) * q) + off; }
        const int nig = WGM * nN, gid = wgid / nig, fm = gid * WGM, gsz = (nM - fm) < WGM ? (nM - fm) : WGM;
        u.pm = fm + ((wgid % nig) % gsz); u.pn = (wgid % nig) / gsz; u.zb = z / nh; u.zh = z % nh;
        u.ao = u.zb * sAb + u.zh * sAh + u.pm * tA; u.bo = u.zb * sBb + u.zh * sBh + u.pn * tB; return true;
    }
};

template <class Epi>
__device__ __forceinline__ void gemm_phase(LAS unsigned char* lds, const Gemm g, const Sched& S, const Epi& E) {
    const int tid = otid(), wid = __builtin_amdgcn_readfirstlane(tid >> 6), lane = tid & 63, wr = wid >> 2, wc = wid & 3, fr = lane & 15, fq = lane >> 4;
    const int nt = g.K / BK;
    unsigned voffA[2], voffB[2];
#pragma unroll
    for (int i = 0; i < 2; ++i) { int R, C; stage_rc(tid * 16 + i * 8192, R, C); const int Rb = Epi::PERM ? ((R & ~31) + perm32(R & 31)) : R;
        voffA[i] = (unsigned)(R * g.lda + C) * 2u; voffB[i] = (unsigned)(Rb * g.ldb + C) * 2u; }
    const size_t kstep = (size_t)(BK * 2);
    const size_t hstepA = (size_t)HALF * g.lda * 2, hstepB = (size_t)HALF * g.ldb * 2;
    const unsigned ldsw = (unsigned)wid * 1024u;
    const int aoff = lds_byte(wr * 64 + fr, fq * 8), boff = lds_byte(wc * 32 + fr, fq * 8);
#define PG8_SA(b, h) (((b) * 2 + (h)) * HTB)
#define PG8_SB(b, h) ((4 + (b) * 2 + (h)) * HTB)
#define PG8_STAGE(bufoff, gbase, voff) do { _Pragma("unroll") for (int _i = 0; _i < 2; ++_i) \
        __builtin_amdgcn_global_load_lds((const unsigned*)((const char*)(gbase) + (voff)[_i]), (LAS unsigned*)(lds + (bufoff) + ldsw + _i * 8192), 16, 0, 0); } while (0)
#define PG8_LDA(dst, b, h) do { _Pragma("unroll") for (int m = 0; m < 4; ++m) _Pragma("unroll") for (int k = 0; k < 2; ++k) dst[m][k] = *(const LAS bf16x8*)(lds + PG8_SA(b, h) + aoff + m * 2048 + k * 1024); } while (0)
#define PG8_LDB(dst, b, h) do { _Pragma("unroll") for (int n = 0; n < 2; ++n) _Pragma("unroll") for (int k = 0; k < 2; ++k) dst[n][k] = *(const LAS bf16x8*)(lds + PG8_SB(b, h) + boff + n * 2048 + k * 1024); } while (0)
#define PG8_MMA(ai, bj, At, Bt) do { __builtin_amdgcn_s_setprio(1); _Pragma("unroll") for (int m = 0; m < 4; ++m) _Pragma("unroll") for (int n = 0; n < 2; ++n) _Pragma("unroll") for (int k = 0; k < 2; ++k) \
        acc[ai][bj][m][n] = __builtin_amdgcn_mfma_f32_16x16x32_bf16(Bt[n][k], At[m][k], acc[ai][bj][m][n], 0, 0, 0); __builtin_amdgcn_s_setprio(0); } while (0)
#define PG8_WAIT_V(n) asm volatile("s_waitcnt vmcnt(" #n ")" ::: "memory")
#define PG8_WAIT_L(n) asm volatile("s_waitcnt lgkmcnt(" #n ")" ::: "memory")
#define PG8_BAR __builtin_amdgcn_s_barrier()
#define PG8_SCHED __builtin_amdgcn_sched_barrier(0)
    Unit cur, nxt; int ui = 0;
    if (!S.next(0, cur)) return;
    f32x4 acc[2][2][4][2];
#pragma unroll
    for (int a = 0; a < 2; ++a)
#pragma unroll
        for (int b = 0; b < 2; ++b)
#pragma unroll
            for (int m = 0; m < 4; ++m)
#pragma unroll
                for (int n = 0; n < 2; ++n) acc[a][b][m][n] = (f32x4){0.f, 0.f, 0.f, 0.f};
    bf16x8 At[4][2], B0[2][2], B1[2][2];
    const char* cA = (const char*)g.A + cur.ao; const char* cB = (const char*)g.Bt + cur.bo;
    PG8_STAGE(PG8_SB(0, 0), cB, voffB); PG8_STAGE(PG8_SA(0, 0), cA, voffA); PG8_STAGE(PG8_SB(0, 1), cB + hstepB, voffB); PG8_STAGE(PG8_SA(0, 1), cA + hstepA, voffA);
    if (wr == 1) PG8_BAR;
    PG8_WAIT_V(4); PG8_BAR;
    PG8_STAGE(PG8_SB(1, 0), cB + kstep, voffB); PG8_STAGE(PG8_SA(1, 0), cA + kstep, voffA); PG8_STAGE(PG8_SB(1, 1), cB + hstepB + kstep, voffB);
    PG8_WAIT_V(6); PG8_BAR;
    for (;;) {
        const Pre pre = E.prefetch(cur, wr, fr);
        const bool has_next = S.next(ui + 1, nxt);
        const char* nA = has_next ? (const char*)g.A + nxt.ao : cA; const char* nB = has_next ? (const char*)g.Bt + nxt.bo : cB;
        for (int t = 0; t < nt; t += 2) {
            const bool last = (t == nt - 2);
            const char* a1 = cA + (size_t)(t + 1) * kstep;
            const char* a2 = last ? nA : cA + (size_t)(t + 2) * kstep; const char* b2 = last ? nB : cB + (size_t)(t + 2) * kstep;
            const char* a3 = a2 + kstep; const char* b3 = b2 + kstep;
            PG8_LDB(B0, 0, 0); PG8_SCHED; PG8_LDA(At, 0, 0); PG8_STAGE(PG8_SA(1, 1), a1 + hstepA, voffA);
            PG8_WAIT_L(8); PG8_BAR; PG8_WAIT_L(0); PG8_MMA(0, 0, At, B0); PG8_BAR; PG8_SCHED;
            PG8_LDB(B1, 0, 1); PG8_STAGE(PG8_SB(0, 0), b2, voffB);
            PG8_BAR; PG8_WAIT_L(0); PG8_MMA(0, 1, At, B1); PG8_BAR;
            PG8_LDA(At, 0, 1); PG8_STAGE(PG8_SA(0, 0), a2, voffA);
            PG8_BAR; PG8_WAIT_L(0); PG8_MMA(1, 0, At, B0); PG8_BAR; PG8_SCHED;
            PG8_STAGE(PG8_SB(0, 1), b2 + hstepB, voffB);
            PG8_WAIT_V(6); PG8_BAR; PG8_MMA(1, 1, At, B1); PG8_BAR;
            PG8_LDB(B0, 1, 0); PG8_SCHED; PG8_LDA(At, 1, 0); PG8_STAGE(PG8_SA(0, 1), a2 + hstepA, voffA);
            PG8_WAIT_L(8); PG8_BAR; PG8_WAIT_L(0); PG8_MMA(0, 0, At, B0); PG8_BAR; PG8_SCHED;
            PG8_LDB(B1, 1, 1); PG8_STAGE(PG8_SB(1, 0), b3, voffB);
            PG8_BAR; PG8_WAIT_L(0); PG8_MMA(0, 1, At, B1); PG8_BAR;
            PG8_LDA(At, 1, 1); PG8_STAGE(PG8_SA(1, 0), a3, voffA);
            PG8_BAR; PG8_WAIT_L(0); PG8_MMA(1, 0, At, B0); PG8_BAR; PG8_SCHED;
            PG8_STAGE(PG8_SB(1, 1), b3 + hstepB, voffB);
            PG8_WAIT_V(6); PG8_BAR; PG8_MMA(1, 1, At, B1); PG8_BAR;
        }
        E(acc, cur, wr, wc, fr, fq, pre);
        if (!has_next) break;
#pragma unroll
        for (int a = 0; a < 2; ++a)
#pragma unroll
            for (int b = 0; b < 2; ++b)
#pragma unroll
                for (int m = 0; m < 4; ++m)
#pragma unroll
                    for (int n = 0; n < 2; ++n) acc[a][b][m][n] = (f32x4){0.f, 0.f, 0.f, 0.f};
        cur = nxt; cA = nA; cB = nB; ++ui;
    }
    PG8_WAIT_V(0);
    if (wr == 0) PG8_BAR;
    PG8_BAR;
#undef PG8_SA
#undef PG8_SB
#undef PG8_STAGE
#undef PG8_LDA
#undef PG8_LDB
#undef PG8_MMA
#undef PG8_WAIT_V
#undef PG8_WAIT_L
#undef PG8_BAR
#undef PG8_SCHED
}
}
using pg8::Unit;
typedef f32x4 Acc[2][2][4][2];

struct GD {
    int type;
    const bf16_t* A; const bf16_t* Bt; int lda, ldb, M, N, K;
    int nb, nh; long sAb, sAh, sBb, sBh, sOb, sOh;
    void* O; int ldc; const float* base; float scale; int act; int split, base0, base1;
    const bf16_t* gate; int add; const float* cs;
    const float* ss; bf16_t* hb; float* ssout; int crot; int zrow; int wgm;
};

__device__ __forceinline__ float rstd_of(const float* ss, int row) { return ss ? rsqrtf(ss[row] * (1.0f / DM) + 1e-6f) : 1.0f; }
struct EpiSwiglu { static constexpr bool PERM = true; bf16_t* O; int ldc; const float* ss;
    __device__ __forceinline__ Pre prefetch(const Unit& u, int wr, int fr) const { return pre_rows(ss, u.pm * 256 + wr * 64 + (int)(threadIdx.x & 63)); }
    __device__ __forceinline__ void operator()(const Acc& acc, const Unit& u, int wr, int wc, int fr, int fq, const Pre& pre) const {
        const int row0 = u.pm * 256 + wr * 64 + fr, col0 = u.pn * 128 + wc * 32 + 8 * fq;
        float rsq[2][4];
#pragma unroll
        for (int ai = 0; ai < 2; ++ai)
#pragma unroll
            for (int m = 0; m < 4; ++m) rsq[ai][m] = rstd_pre(ss, pre_get(pre, ai, m, fr));
#pragma unroll
        for (int ai = 0; ai < 2; ++ai)
#pragma unroll
            for (int m = 0; m < 4; ++m) {
                f32x4 v0, v1; const float rs = rsq[ai][m];
#pragma unroll
                for (int e = 0; e < 4; ++e) { v0[e] = silu_f(acc[ai][0][m][0][e] * rs) * (acc[ai][1][m][0][e] * rs); v1[e] = silu_f(acc[ai][0][m][1][e] * rs) * (acc[ai][1][m][1][e] * rs); }
                *(u32x4*)(O + (size_t)(row0 + ai * 128 + m * 16) * ldc + col0) = pk8(v0, v1);
            }
    }
};
struct EpiF32 { static constexpr bool PERM = true; float* O; int ldc; const float* base; float scale; long sOb, sOh; bf16_t* hb; float* ssout; int zrow;
    __device__ __forceinline__ Pre prefetch(const Unit&, int, int) const { Pre p; p.v[0] = 1.0f; p.v[1] = 1.0f; return p; }
    __device__ __forceinline__ void operator()(const Acc& acc, const Unit& u, int wr, int wc, int fr, int fq, const Pre& pre) const {
        const int row0 = u.pm * 256 + wr * 64 + fr, col0 = u.pn * 256 + wc * 32 + 8 * fq;
        const size_t zo = (size_t)(u.zb * sOb + u.zh * sOh);
#pragma unroll
        for (int ai = 0; ai < 2; ++ai) {
            f32x4 bv[4][2][2];
            if (base) {
#pragma unroll
                for (int m = 0; m < 4; ++m) { const size_t off = zo + (size_t)(row0 + ai * 128 + m * 16) * ldc + col0;
#pragma unroll
                    for (int bj = 0; bj < 2; ++bj)
#pragma unroll
                        for (int n = 0; n < 2; ++n) bv[m][bj][n] = *(const f32x4*)(base + off + bj * 128 + n * 4); }
            }
#pragma unroll
            for (int m = 0; m < 4; ++m) { const size_t off = zo + (size_t)(row0 + ai * 128 + m * 16) * ldc + col0; float sq = 0.f;
#pragma unroll
                for (int bj = 0; bj < 2; ++bj) { f32x4 v0 = acc[ai][bj][m][0] * scale, v1 = acc[ai][bj][m][1] * scale;
                    if (base) { v0 += bv[m][bj][0]; v1 += bv[m][bj][1]; }
                    *(f32x4*)(O + off + bj * 128) = v0; *(f32x4*)(O + off + bj * 128 + 4) = v1;
                    if (hb) { *(u32x4*)(hb + off + bj * 128) = pk8(v0, v1);
                        sq += (v0[0] * v0[0] + v0[1] * v0[1]) + (v0[2] * v0[2] + v0[3] * v0[3]) + (v1[0] * v1[0] + v1[1] * v1[1]) + (v1[2] * v1[2] + v1[3] * v1[3]); } }
                if (ssout) { sq += __shfl_xor(sq, 16); sq += __shfl_xor(sq, 32); if (fq == 0) __hip_atomic_fetch_add(ssout + u.zb * zrow + row0 + ai * 128 + m * 16, sq, __ATOMIC_RELAXED, __HIP_MEMORY_SCOPE_AGENT); } }
            asm volatile("" ::: "memory");
        }
    }
};
struct EpiProj { static constexpr bool PERM = true; bf16_t* O; int ldc; const float* cs; const float* ss;
    __device__ __forceinline__ Pre prefetch(const Unit& u, int wr, int fr) const { return pre_rows(ss, u.pm * 256 + wr * 64 + (int)(threadIdx.x & 63)); }
    __device__ __forceinline__ void operator()(const Acc& acc, const Unit& u, int wr, int wc, int fr, int fq, const Pre& pre) const {
        const int tile = u.pn; int mode = 0; float scale0 = 1.f;
        if (tile < 36) { const int tg = tile % 12; if (tg < 4) { mode = 1; scale0 = 0.08838834764831845f * LOG2E; } else if (tg < 8) mode = 1; }
        else if (tile < 40) mode = 1;
        else if (tile < 44) { mode = 1; scale0 = 0.08838834764831845f; }
        else if (tile >= 52) mode = 2;
        const int row0 = u.pm * 256 + wr * 64 + fr;
        float rsq[2][4];
#pragma unroll
        for (int ai = 0; ai < 2; ++ai)
#pragma unroll
            for (int m = 0; m < 4; ++m) rsq[ai][m] = rstd_pre(ss, pre_get(pre, ai, m, fr));
        if (mode == 1) {
            const int head2 = wc >> 1, i0 = 32 * (wc & 1) + 8 * fq;
#pragma unroll
            for (int ai = 0; ai < 2; ++ai) {
                f32x4 cv[4][4]; float rsv[4];
#pragma unroll
                for (int m = 0; m < 4; ++m) { const int row = row0 + ai * 128 + m * 16; rsv[m] = rsq[ai][m];
                    const f32x4* cp = (const f32x4*)(cs + (size_t)row * 128 + i0 * 2); cv[m][0] = cp[0]; cv[m][1] = cp[1]; cv[m][2] = cp[2]; cv[m][3] = cp[3]; }
#pragma unroll
                for (int m = 0; m < 4; ++m) { const int row = row0 + ai * 128 + m * 16; const float scale = scale0 * rsv[m];
                    const f32x4 c0 = cv[m][0], c1 = cv[m][1], c2 = cv[m][2], c3 = cv[m][3];
                    const f32x4 xa = acc[ai][0][m][0], xb = acc[ai][0][m][1], ya = acc[ai][1][m][0], yb = acc[ai][1][m][1];
                    f32x4 o1a, o1b, o2a, o2b;
                    o1a[0] = (xa[0] * c0[0] - ya[0] * c0[1]) * scale; o2a[0] = (ya[0] * c0[0] + xa[0] * c0[1]) * scale;
                    o1a[1] = (xa[1] * c0[2] - ya[1] * c0[3]) * scale; o2a[1] = (ya[1] * c0[2] + xa[1] * c0[3]) * scale;
                    o1a[2] = (xa[2] * c1[0] - ya[2] * c1[1]) * scale; o2a[2] = (ya[2] * c1[0] + xa[2] * c1[1]) * scale;
                    o1a[3] = (xa[3] * c1[2] - ya[3] * c1[3]) * scale; o2a[3] = (ya[3] * c1[2] + xa[3] * c1[3]) * scale;
                    o1b[0] = (xb[0] * c2[0] - yb[0] * c2[1]) * scale; o2b[0] = (yb[0] * c2[0] + xb[0] * c2[1]) * scale;
                    o1b[1] = (xb[1] * c2[2] - yb[1] * c2[3]) * scale; o2b[1] = (yb[1] * c2[2] + xb[1] * c2[3]) * scale;
                    o1b[2] = (xb[2] * c3[0] - yb[2] * c3[1]) * scale; o2b[2] = (yb[2] * c3[0] + xb[2] * c3[1]) * scale;
                    o1b[3] = (xb[3] * c3[2] - yb[3] * c3[3]) * scale; o2b[3] = (yb[3] * c3[2] + xb[3] * c3[3]) * scale;
                    bf16_t* rp = O + (size_t)row * ldc + tile * 256 + head2 * 128 + i0;
                    *(u32x4*)rp = pk8(o1a, o1b); *(u32x4*)(rp + 64) = pk8(o2a, o2b); }
                asm volatile("" ::: "memory"); }
        } else {
            const int col0 = tile * 256 + wc * 32 + 8 * fq;
#pragma unroll
            for (int ai = 0; ai < 2; ++ai)
#pragma unroll
                for (int m = 0; m < 4; ++m) { const float rs = rsq[ai][m];
#pragma unroll
                    for (int bj = 0; bj < 2; ++bj) { f32x4 v0 = acc[ai][bj][m][0] * rs, v1 = acc[ai][bj][m][1] * rs;
                        if (mode == 2) {
#pragma unroll
                            for (int e = 0; e < 4; ++e) { v0[e] = silu_f(v0[e]); v1[e] = silu_f(v1[e]); } }
                        *(u32x4*)(O + (size_t)(row0 + ai * 128 + m * 16) * ldc + col0 + bj * 128) = pk8(v0, v1); } }
        }
    }
};
struct EpiAct { static constexpr bool PERM = true; bf16_t* O; int ldc; float scale; int act; int split, base0, base1; long sOb, sOh; const float* ss;
    __device__ __forceinline__ Pre prefetch(const Unit& u, int wr, int fr) const { return pre_rows(ss, u.pm * 256 + wr * 64 + (int)(threadIdx.x & 63)); }
    __device__ __forceinline__ void operator()(const Acc& acc, const Unit& u, int wr, int wc, int fr, int fq, const Pre& pre) const {
        const int colt = (u.pn < split) ? base0 + u.pn * 256 : base1 + (u.pn - split) * 256;
        const int row0 = u.pm * 256 + wr * 64 + fr, col0 = colt + wc * 32 + 8 * fq;
        bf16_t* Oz = O + (size_t)(u.zb * sOb + u.zh * sOh);
        float rsq[2][4];
#pragma unroll
        for (int ai = 0; ai < 2; ++ai)
#pragma unroll
            for (int m = 0; m < 4; ++m) rsq[ai][m] = rstd_pre(ss, pre_get(pre, ai, m, fr));
#pragma unroll
        for (int ai = 0; ai < 2; ++ai)
#pragma unroll
            for (int m = 0; m < 4; ++m) { const float rs = scale * rsq[ai][m];
#pragma unroll
                for (int bj = 0; bj < 2; ++bj) { f32x4 v0 = acc[ai][bj][m][0] * rs, v1 = acc[ai][bj][m][1] * rs;
                    if (act == 1) {
#pragma unroll
                        for (int e = 0; e < 4; ++e) { v0[e] = sigm_f(v0[e]); v1[e] = sigm_f(v1[e]); } }
                    *(u32x4*)(Oz + (size_t)(row0 + ai * 128 + m * 16) * ldc + col0 + bj * 128) = pk8(v0, v1); } }
    }
};
struct EpiSoftmax { static constexpr bool PERM = true; bf16_t* O; int ldc; long sOb, sOh; LAS float* X; const float* ss; int zrow;
    __device__ __forceinline__ Pre prefetch(const Unit& u, int wr, int fr) const { return pre_rows(ss, u.zb * zrow + u.pm * 256 + wr * 64 + (int)(threadIdx.x & 63)); }
    __device__ __forceinline__ void operator()(const Acc& acc, const Unit& u, int wr, int wc, int fr, int fq, const Pre& pre) const {
        const int row0 = u.pm * 256 + wr * 64 + fr, col0 = wc * 32 + 8 * fq;
        bf16_t* Oz = O + (size_t)(u.zb * sOb + u.zh * sOh);
        float rs[2][4];
#pragma unroll
        for (int ai = 0; ai < 2; ++ai)
#pragma unroll
            for (int m = 0; m < 4; ++m) rs[ai][m] = rstd_pre(ss, pre_get(pre, ai, m, fr));
#pragma unroll
        for (int ai = 0; ai < 2; ++ai)
#pragma unroll
            for (int m = 0; m < 4; ++m) { float mx = -INFINITY;
#pragma unroll
                for (int bj = 0; bj < 2; ++bj)
#pragma unroll
                    for (int n = 0; n < 2; ++n) { const f32x4 a = acc[ai][bj][m][n]; mx = fmaxf(mx, fmaxf(fmaxf(a[0], a[1]), fmaxf(a[2], a[3]))); }
                mx *= rs[ai][m];
                mx = fmaxf(mx, __shfl_xor(mx, 16)); mx = fmaxf(mx, __shfl_xor(mx, 32));
                if (fq == 0) X[(ai * 128 + wr * 64 + m * 16 + fr) * 4 + wc] = mx; }
        asm volatile("s_waitcnt lgkmcnt(0)" ::: "memory"); __builtin_amdgcn_s_barrier(); asm volatile("" ::: "memory");
        float rmx[2][4];
#pragma unroll
        for (int ai = 0; ai < 2; ++ai)
#pragma unroll
            for (int m = 0; m < 4; ++m) { const f32x4 q = *(const LAS f32x4*)(X + (ai * 128 + wr * 64 + m * 16 + fr) * 4);
                const float mx = fmaxf(fmaxf(q[0], q[1]), fmaxf(q[2], q[3])); rmx[ai][m] = mx; float sm = 0.f; const float r = rs[ai][m];
#pragma unroll
                for (int bj = 0; bj < 2; ++bj)
#pragma unroll
                    for (int n = 0; n < 2; ++n)
#pragma unroll
                        for (int e = 0; e < 4; ++e) sm += __builtin_amdgcn_exp2f(acc[ai][bj][m][n][e] * r - mx);
                sm += __shfl_xor(sm, 16); sm += __shfl_xor(sm, 32);
                if (fq == 0) X[1024 + (ai * 128 + wr * 64 + m * 16 + fr) * 4 + wc] = sm; }
        asm volatile("s_waitcnt lgkmcnt(0)" ::: "memory"); __builtin_amdgcn_s_barrier(); asm volatile("" ::: "memory");
#pragma unroll
        for (int ai = 0; ai < 2; ++ai)
#pragma unroll
            for (int m = 0; m < 4; ++m) { const f32x4 q = *(const LAS f32x4*)(X + 1024 + (ai * 128 + wr * 64 + m * 16 + fr) * 4);
                const float inv = 1.0f / ((q[0] + q[1]) + (q[2] + q[3])); const float mx = rmx[ai][m], r = rs[ai][m];
#pragma unroll
                for (int bj = 0; bj < 2; ++bj) { f32x4 v0, v1;
#pragma unroll
                    for (int e = 0; e < 4; ++e) { v0[e] = __builtin_amdgcn_exp2f(acc[ai][bj][m][0][e] * r - mx) * inv; v1[e] = __builtin_amdgcn_exp2f(acc[ai][bj][m][1][e] * r - mx) * inv; }
                    *(u32x4*)(Oz + (size_t)(row0 + ai * 128 + m * 16) * ldc + col0 + bj * 128) = pk8(v0, v1); } }
    }
};
struct EpiGate { static constexpr bool PERM = true; bf16_t* O; int ldc; const bf16_t* gate; int add;
    __device__ __forceinline__ Pre prefetch(const Unit&, int, int) const { Pre p; p.v[0] = 1.0f; p.v[1] = 1.0f; return p; }
    __device__ __forceinline__ void operator()(const Acc& acc, const Unit& u, int wr, int wc, int fr, int fq, const Pre& pre) const {
        const int row0 = u.pm * 256 + wr * 64 + fr, col0 = u.pn * 256 + wc * 32 + 8 * fq;
#pragma unroll
        for (int ai = 0; ai < 2; ++ai) {
            u32x4 gw[4][2], pw[4][2];
#pragma unroll
            for (int m = 0; m < 4; ++m)
#pragma unroll
                for (int bj = 0; bj < 2; ++bj) { const size_t off = (size_t)(row0 + ai * 128 + m * 16) * ldc + col0 + bj * 128;
                    gw[m][bj] = *(const u32x4*)(gate + off); if (add) pw[m][bj] = *(const u32x4*)(O + off); }
#pragma unroll
            for (int m = 0; m < 4; ++m)
#pragma unroll
                for (int bj = 0; bj < 2; ++bj) { const size_t off = (size_t)(row0 + ai * 128 + m * 16) * ldc + col0 + bj * 128;
                    const u32x4 g = gw[m][bj];
                    f32x4 v0 = acc[ai][bj][m][0], v1 = acc[ai][bj][m][1];
                    v0[0] *= bflo(g.x); v0[1] *= bfhi(g.x); v0[2] *= bflo(g.y); v0[3] *= bfhi(g.y);
                    v1[0] *= bflo(g.z); v1[1] *= bfhi(g.z); v1[2] *= bflo(g.w); v1[3] *= bfhi(g.w);
                    if (add) { const u32x4 q = pw[m][bj];
                        v0[0] += bflo(q.x); v0[1] += bfhi(q.x); v0[2] += bflo(q.y); v0[3] += bfhi(q.y);
                        v1[0] += bflo(q.z); v1[1] += bfhi(q.z); v1[2] += bflo(q.w); v1[3] += bfhi(q.w); }
                    *(u32x4*)(O + off) = pk8(v0, v1); }
            asm volatile("" ::: "memory");
        }
    }
};

__device__ __forceinline__ int srccol64(int mode, int p0, int n0) {
    if (mode == 0) return p0 + n0;
    const int tile = n0 >> 8, rem = n0 & 255, bj = rem >> 7, j = rem & 127;
    if (mode == 1) return bj * DFF + tile * 128 + j;
    bool rope;
    if (tile < 36) rope = (tile % 12) < 8; else rope = tile < 44;
    if (!rope) return n0;
    return tile * 256 + (j >> 6) * 128 + bj * 64 + (j & 63);
}
__device__ __forceinline__ void conv_job(LAS unsigned char* lds, const float* src, int ld, int K, bf16_t* dst, int nrows, int mode, int p0, const float* gain = nullptr, int rank0 = 0, int nranks = 0) {
    const int tid = otid(), c4 = tid & 31, kr = tid >> 5;
    const int nNt = nrows >> 7, nKt = K >> 7, nu = nNt * nKt;
    if (nranks == 0) nranks = gridDim.x;
    int u = (int)blockIdx.x - rank0; if (u < 0 || u >= nu) return;
    f32x4 va[8], vb[8], gq[2];
#define CONV_LOAD(dstv, uu) do { const int n_ = ((uu) % nNt) * 128, k_ = ((uu) / nNt) * 128; \
        const float* sp_ = src + (size_t)(k_ + kr * 8) * ld + srccol64(mode, p0, n_ + (c4 >> 4) * 64) + (c4 & 15) * 4; \
        _Pragma("unroll") for (int it = 0; it < 8; ++it) dstv[it] = __builtin_nontemporal_load((const f32x4*)(sp_ + (size_t)it * ld)); } while (0)
#define CONV_GAIN(uu) do { if (gain) { const int kg_ = ((uu) / nNt) * 128 + kr * 8; gq[0] = *(const f32x4*)(gain + kg_); gq[1] = *(const f32x4*)(gain + kg_ + 4); } } while (0)
#define CONV_EMIT(v, uu, ugain, unext) do { const int n0 = ((uu) % nNt) * 128, k0 = ((uu) / nNt) * 128; \
        if (gain) { _Pragma("unroll") for (int it = 0; it < 4; ++it) { v[it] *= gq[0][it]; v[it + 4] *= gq[1][it]; } } \
        asm volatile("s_waitcnt lgkmcnt(0)" ::: "memory"); __builtin_amdgcn_s_barrier(); asm volatile("" ::: "memory");     \
        _Pragma("unroll") for (int e = 0; e < 4; ++e) { \
            u32x4 w; w.x = pk2(v[0][e], v[1][e]); w.y = pk2(v[2][e], v[3][e]); w.z = pk2(v[4][e], v[5][e]); w.w = pk2(v[6][e], v[7][e]); \
            *(LAS u32x4*)(lds + (c4 + 32 * e) * 272 + kr * 16) = w; } \
        if ((ugain) < nu) CONV_GAIN(ugain); \
        if ((unext) < nu) CONV_LOAD(v, unext); \
        asm volatile("s_waitcnt lgkmcnt(0)" ::: "memory"); __builtin_amdgcn_s_barrier(); asm volatile("" ::: "memory"); \
        _Pragma("unroll") for (int i = 0; i < 4; ++i) { const int p = tid + 512 * i, n = p >> 4, pc = p & 15; \
            const u32x4 w = *(const LAS u32x4*)(lds + ((n >> 2) + 32 * (n & 3)) * 272 + pc * 16); \
            *(u32x4*)(dst + (size_t)(n0 + n) * K + k0 + pc * 8) = w; } } while (0)
    CONV_LOAD(va, u);
    CONV_GAIN(u);
    if (u + nranks < nu) CONV_LOAD(vb, u + nranks);
    for (; u < nu; u += 2 * nranks) {
        CONV_EMIT(va, u, u + nranks, u + 2 * nranks);
        if (u + nranks < nu) CONV_EMIT(vb, u + nranks, u + 2 * nranks, u + 3 * nranks);
    }
#undef CONV_LOAD
#undef CONV_EMIT
#undef CONV_GAIN
}
__device__ __forceinline__ void cast_job(const float* src, const float* gain, bf16_t* dst, int rows, int cols) {
    const int gt = blockIdx.x * 512 + otid(), nt = gridDim.x * 512, per = cols >> 3;
    for (int idx = gt; idx < rows * per; idx += nt) { const int k = idx / per, c = (idx % per) * 8; const float g = gain[k];
        const f32x4 a = __builtin_nontemporal_load((const f32x4*)(src + (size_t)k * cols + c)), b = __builtin_nontemporal_load((const f32x4*)(src + (size_t)k * cols + c + 4));
        *(u32x4*)(dst + (size_t)k * cols + c) = pk8(a * g, b * g); }
}
__device__ __forceinline__ void norm_rows(const float* src, const float* gain, bf16_t* dst, int nrows, float* ssq = nullptr) {
    const int tid = otid(), lane = tid & 63, gw = blockIdx.x * 8 + (tid >> 6), nw = gridDim.x * 8;
    for (int row = gw; row < nrows; row += nw) {
        const f32x4* p = (const f32x4*)(src + (size_t)row * DM); f32x4 v[8]; float ss = 0.f;
#pragma unroll
        for (int i = 0; i < 8; ++i) { v[i] = __builtin_nontemporal_load(p + i * 64 + lane); ss += v[i][0] * v[i][0] + v[i][1] * v[i][1] + v[i][2] * v[i][2] + v[i][3] * v[i][3]; }
        ss = wave_sum(ss); const float r = gain ? rsqrtf(ss * (1.0f / DM) + 1e-6f) : 1.0f;
        if (!gain && lane == 0) ssq[row] = ss;
#pragma unroll
        for (int i = 0; i < 8; ++i) { const f32x4 gn = gain ? ((const f32x4*)gain)[i * 64 + lane] : (f32x4){1.f, 1.f, 1.f, 1.f}; u32x2 w; w.x = pk2(v[i][0] * r * gn[0], v[i][1] * r * gn[1]); w.y = pk2(v[i][2] * r * gn[2], v[i][3] * r * gn[3]);
            *(u32x2*)(dst + (size_t)row * DM + (i * 64 + lane) * 4) = w; }
    }
}
__device__ __forceinline__ void final_norm(float* h, const float* gain, int nrows) {
    const int tid = otid(), lane = tid & 63, gw = blockIdx.x * 8 + (tid >> 6), nw = gridDim.x * 8;
    f32x4 gn[8];
#pragma unroll
    for (int i = 0; i < 8; ++i) gn[i] = ((const f32x4*)gain)[i * 64 + lane];
    for (int row = gw; row < nrows; row += nw) {
        f32x4* p = (f32x4*)(h + (size_t)row * DM); f32x4 v[8]; float ss = 0.f;
#pragma unroll
        for (int i = 0; i < 8; ++i) { v[i] = p[i * 64 + lane]; ss += v[i][0] * v[i][0] + v[i][1] * v[i][1] + v[i][2] * v[i][2] + v[i][3] * v[i][3]; }
        ss = wave_sum(ss); const float r = rsqrtf(ss * (1.0f / DM) + 1e-6f);
#pragma unroll
        for (int i = 0; i < 8; ++i) __builtin_nontemporal_store(v[i] * r * gn[i], p + i * 64 + lane);
    }
}
__device__ __forceinline__ void cs_table(const int* pos, float* cs) {
    const int gt = blockIdx.x * 512 + otid(), nt = gridDim.x * 512;
    const bool inv_const = (nt & 63) == 0;
    float inv = powf(10000.0f, -(float)(gt & 63) * (1.0f / 64.0f));
    for (int e = gt; e < T_TOK * 64; e += nt) { const int t = e >> 6, i = e & 63;
        if (!inv_const) inv = powf(10000.0f, -(float)i * (1.0f / 64.0f));
        const float ang = (float)pos[t] * inv;
        double rev = (double)ang * 0.15915494309189535; rev -= rint(rev); const float fr = (float)rev;
        f32x2 o; o.x = __builtin_amdgcn_cosf(fr); o.y = __builtin_amdgcn_sinf(fr); *(f32x2*)(cs + (size_t)e * 2) = o; }
}
__device__ __forceinline__ void softmax_rows(const float* sc, bf16_t* P, int nrows) {
    const int tid = otid(), lane = tid & 63, gw = blockIdx.x * 8 + (tid >> 6), nw = gridDim.x * 8;
    for (int row = gw; row < nrows; row += nw) {
        const f32x4 v = *(const f32x4*)(sc + (size_t)row * 256 + lane * 4);
        const float mx = wave_max(fmaxf(fmaxf(v[0], v[1]), fmaxf(v[2], v[3])));
        f32x4 p; p[0] = __builtin_amdgcn_exp2f(v[0] - mx); p[1] = __builtin_amdgcn_exp2f(v[1] - mx); p[2] = __builtin_amdgcn_exp2f(v[2] - mx); p[3] = __builtin_amdgcn_exp2f(v[3] - mx);
        const float inv = 1.0f / wave_sum(p[0] + p[1] + p[2] + p[3]);
        u32x2 w; w.x = pk2(p[0] * inv, p[1] * inv); w.y = pk2(p[2] * inv, p[3] * inv);
        *(u32x2*)(P + (size_t)row * 256 + lane * 4) = w;
    }
}

__device__ __forceinline__ void dil_attn(LAS unsigned char* lds, bf16_t* proj, float* lse2) {
    const int tid = otid(), wid = __builtin_amdgcn_readfirstlane(tid >> 6), lane = tid & 63, fr = lane & 15, g4 = lane >> 4;
    LAS unsigned char* Kimg = lds; LAS unsigned char* Vimg = lds + 69632;
    u32x4 kr[8], vr[8]; bf16x8 qn[4];
#define DIL_DECODE(unit_) const int jc = (unit_) & 63; int rest = (unit_) >> 6; const int h = rest & 7; rest >>= 3; const int g = rest % 3, b = rest / 3; \
        const int r = 1 << (2 * g), nb = 64 >> (2 * g), c = jc / nb, j = jc % nb; const int qcol = g * 3072 + h * 128; const size_t tb0 = (size_t)b * SEQ + c;
#define DIL_LOAD(unit_) do { DIL_DECODE(unit_) \
        _Pragma("unroll") for (int i = 0; i < 8; ++i) { const int q = tid + 512 * i, row = q >> 4, pc = q & 15; \
            const int pk = (j == 0 && row < 128) ? row : 128 * (j - 1) + row; \
            const bf16_t* rp = proj + (tb0 + (size_t)pk * r) * NP1 + qcol + pc * 8; \
            kr[i] = *(const u32x4*)(rp + 1024); vr[i] = *(const u32x4*)(rp + 2048); } \
        const size_t tq_ = tb0 + (size_t)(128 * j + 16 * wid + fr) * r; \
        _Pragma("unroll") for (int kk = 0; kk < 4; ++kk) qn[kk] = *(const bf16x8*)(proj + tq_ * NP1 + qcol + 32 * kk + 8 * g4); } while (0)
    int unit = blockIdx.x;
    if (unit < 3072) DIL_LOAD(unit);
    for (; unit < 3072; unit += gridDim.x) {
        DIL_DECODE(unit)
        const size_t tq = tb0 + (size_t)(128 * j + 16 * wid + fr) * r;
        __syncthreads();
#pragma unroll
        for (int i = 0; i < 8; ++i) { const int q = tid + 512 * i, row = q >> 4, pc = q & 15;
            *(LAS u32x4*)(Kimg + row * 272 + pc * 16) = kr[i]; *(LAS u32x4*)(Vimg + row * 288 + pc * 16) = vr[i]; }
        bf16x8 qf[4];
#pragma unroll
        for (int kk = 0; kk < 4; ++kk) qf[kk] = qn[kk];
        { const int un = unit + gridDim.x; if (un < 3072) DIL_LOAD(un); }
        asm volatile("s_waitcnt lgkmcnt(0)" ::: "memory"); __builtin_amdgcn_s_barrier(); asm volatile("" ::: "memory");
        const int tb = 2 * (wid >> 1);
        f32x4 s[10];
#pragma unroll
        for (int t = 0; t < 10; ++t) { s[t] = (f32x4){0.f, 0.f, 0.f, 0.f};
#pragma unroll
            for (int kk = 0; kk < 4; ++kk) { const bf16x8 a = *(const LAS bf16x8*)(Kimg + (16 * (tb + t) + fr) * 272 + (32 * kk + 8 * g4) * 2); s[t] = MFMA16(a, qf[kk], s[t]); } }
        const int iq = 16 * wid + fr; float mx = -INFINITY;
#pragma unroll
        for (int t = 0; t < 10; ++t)
#pragma unroll
            for (int e = 0; e < 4; ++e) { const int kkey = 16 * (tb + t) + 4 * g4 + e;
                const bool valid = (kkey >= iq) && (kkey <= iq + 128) && (j > 0 || kkey >= 128);
                s[t][e] = valid ? s[t][e] : -INFINITY; mx = fmaxf(mx, s[t][e]); }
        mx = fmaxf(mx, __shfl_xor(mx, 16)); mx = fmaxf(mx, __shfl_xor(mx, 32));
        float l = 0.f;
#pragma unroll
        for (int t = 0; t < 10; ++t)
#pragma unroll
            for (int e = 0; e < 4; ++e) { s[t][e] = __builtin_amdgcn_exp2f(s[t][e] - mx); l += s[t][e]; }
        l += __shfl_xor(l, 16); l += __shfl_xor(l, 32);
        bf16x8 pf[5];
#pragma unroll
        for (int pp = 0; pp < 5; ++pp) pf[pp] = __builtin_bit_cast(bf16x8, pk8(s[2 * pp], s[2 * pp + 1]));
        f32x4 o[8];
#pragma unroll
        for (int cc = 0; cc < 8; ++cc) { o[cc] = (f32x4){0.f, 0.f, 0.f, 0.f};
#pragma unroll
            for (int pp = 0; pp < 5; ++pp) { LAS unsigned char* a0 = Vimg + (16 * (tb + 2 * pp) + 4 * g4 + (fr >> 2)) * 288 + 32 * cc + 8 * (fr & 3);
                const bf16x8 a = tr2(a0, a0 + 16 * 288); o[cc] = MFMA16(a, pf[pp], o[cc]); } }
        const float inv = 1.0f / l;
        bf16_t* op = proj + tq * NP1 + qcol + 16 * (g4 & 1) + 8 * (g4 >> 1);
#pragma unroll
        for (int pr = 0; pr < 4; ++pr) { u32x2 wa, wb; wa.x = pk2(o[2 * pr][0] * inv, o[2 * pr][1] * inv); wa.y = pk2(o[2 * pr][2] * inv, o[2 * pr][3] * inv);
            wb.x = pk2(o[2 * pr + 1][0] * inv, o[2 * pr + 1][1] * inv); wb.y = pk2(o[2 * pr + 1][2] * inv, o[2 * pr + 1][3] * inv);
            *(u32x4*)(op + 32 * pr) = widen16(wa, wb); }
        if (g4 == 0) lse2[(tq * 3 + g) * 8 + h] = mx + log2f(l);
    }
#undef DIL_DECODE
#undef DIL_LOAD
}
__device__ __forceinline__ void dil_combine(bf16_t* proj, const float* lse2) {
    const int gt = blockIdx.x * 512 + otid(), nt = gridDim.x * 512;
    for (int idx0 = gt; idx0 < T_TOK * 128; idx0 += 4 * nt) {
        u32x4 w0[4], w1[4], w2[4]; float l0[4], l1[4], l2[4];
#pragma unroll
        for (int k = 0; k < 4; ++k) { const int idx = idx0 + k * nt; if (idx < T_TOK * 128) { const size_t t = idx >> 7; const int h = (idx >> 4) & 7, pc = idx & 15;
            l0[k] = lse2[(t * 3 + 0) * 8 + h]; l1[k] = lse2[(t * 3 + 1) * 8 + h]; l2[k] = lse2[(t * 3 + 2) * 8 + h];
            const bf16_t* p0 = proj + t * NP1 + h * 128 + pc * 8; w0[k] = *(const u32x4*)p0; w1[k] = *(const u32x4*)(p0 + 3072); w2[k] = *(const u32x4*)(p0 + 6144); } }
#pragma unroll
        for (int k = 0; k < 4; ++k) { const int idx = idx0 + k * nt; if (idx < T_TOK * 128) { const size_t t = idx >> 7; const int h = (idx >> 4) & 7, pc = idx & 15;
            const float m = fmaxf(l0[k], fmaxf(l1[k], l2[k])); float a0 = __builtin_amdgcn_exp2f(l0[k] - m), a1 = __builtin_amdgcn_exp2f(l1[k] - m), a2 = __builtin_amdgcn_exp2f(l2[k] - m);
            const float inv = 1.0f / (a0 + a1 + a2); a0 *= inv; a1 *= inv; a2 *= inv;
            const u32x4 x0 = w0[k], x1 = w1[k], x2 = w2[k]; u32x4 o;
            o.x = pk2(a0 * bflo(x0.x) + a1 * bflo(x1.x) + a2 * bflo(x2.x), a0 * bfhi(x0.x) + a1 * bfhi(x1.x) + a2 * bfhi(x2.x));
            o.y = pk2(a0 * bflo(x0.y) + a1 * bflo(x1.y) + a2 * bflo(x2.y), a0 * bfhi(x0.y) + a1 * bfhi(x1.y) + a2 * bfhi(x2.y));
            o.z = pk2(a0 * bflo(x0.z) + a1 * bflo(x1.z) + a2 * bflo(x2.z), a0 * bfhi(x0.z) + a1 * bfhi(x1.z) + a2 * bfhi(x2.z));
            o.w = pk2(a0 * bflo(x0.w) + a1 * bflo(x1.w) + a2 * bflo(x2.w), a0 * bfhi(x0.w) + a1 * bfhi(x1.w) + a2 * bfhi(x2.w));
            *(u32x4*)(proj + t * NP1 + h * 128 + pc * 8) = o; } }
    }
}

__device__ __forceinline__ float ret_l2g(int h) { return log2f(1.0f - exp2f(-5.0f - (float)h)); }
__device__ __forceinline__ void ret_kv(LAS unsigned char* lds, const bf16_t* proj, bf16_t* kvb) {
    const int tid = otid(), wid = __builtin_amdgcn_readfirstlane(tid >> 6), lane = tid & 63, fr = lane & 15, g4 = lane >> 4;
    LAS unsigned char* Kimg = lds; LAS unsigned char* Vimg = lds + 38912;
    u32x4 kr[4], vr[8];
#define RKV_LOAD(unit_) do { const int n_ = (unit_) & 63, h_ = ((unit_) >> 6) & 7, b_ = (unit_) >> 9; const size_t t0_ = (size_t)b_ * SEQ + 128 * n_; \
        _Pragma("unroll") for (int i = 0; i < 4; ++i) { const int q = tid + 512 * i, row = q >> 4, pc = q & 15; kr[i] = *(const u32x4*)(proj + (t0_ + row) * NP1 + RK0 + h_ * 128 + pc * 8); } \
        _Pragma("unroll") for (int i = 0; i < 8; ++i) { const int q = tid + 512 * i, row = q >> 5, pc = q & 31; vr[i] = *(const u32x4*)(proj + (t0_ + row) * NP1 + RV0 + h_ * 256 + pc * 8); } } while (0)
    int unit = blockIdx.x;
    if (unit < 1024) RKV_LOAD(unit);
    for (; unit < 1024; unit += gridDim.x) {
        const int h = (unit >> 6) & 7;
        const float l2g = ret_l2g(h);
        __syncthreads();
#pragma unroll
        for (int i = 0; i < 4; ++i) { const int q = tid + 512 * i, row = q >> 4, pc = q & 15;
            const u32x4 w = kr[i];
            const float d = __builtin_amdgcn_exp2f((float)(127 - row) * l2g);
            u32x4 o; o.x = pk2(bflo(w.x) * d, bfhi(w.x) * d); o.y = pk2(bflo(w.y) * d, bfhi(w.y) * d); o.z = pk2(bflo(w.z) * d, bfhi(w.z) * d); o.w = pk2(bflo(w.w) * d, bfhi(w.w) * d);
            *(LAS u32x4*)(Kimg + row * 304 + pc * 16) = o; }
#pragma unroll
        for (int i = 0; i < 8; ++i) { const int q = tid + 512 * i, row = q >> 5, pc = q & 31;
            *(LAS u32x4*)(Vimg + row * 560 + pc * 16) = vr[i]; }
        { const int un = unit + gridDim.x; if (un < 1024) RKV_LOAD(un); }
        asm volatile("s_waitcnt lgkmcnt(0)" ::: "memory"); __builtin_amdgcn_s_barrier(); asm volatile("" ::: "memory");
        f32x4 acc[16];
#pragma unroll
        for (int cc = 0; cc < 16; ++cc) acc[cc] = (f32x4){0.f, 0.f, 0.f, 0.f};
#pragma unroll
        for (int ks = 0; ks < 4; ++ks) {
            LAS unsigned char* ka = Kimg + (32 * ks + 8 * g4 + (fr >> 2)) * 304 + 32 * wid + 8 * (fr & 3);
            const bf16x8 a = tr2(ka, ka + 4 * 304);
#pragma unroll
            for (int cc = 0; cc < 16; ++cc) { LAS unsigned char* va = Vimg + (32 * ks + 8 * g4 + (fr >> 2)) * 560 + 32 * cc + 8 * (fr & 3);
                const bf16x8 bb = tr2(va, va + 4 * 560); acc[cc] = MFMA16(a, bb, acc[cc]); }
        }
        bf16_t* op = kvb + (size_t)unit * 32768 + 16 * wid + 8 * (g4 >> 1) + (size_t)(16 * (g4 & 1) + fr) * 128;
#pragma unroll
        for (int pr = 0; pr < 8; ++pr) { u32x2 wa, wb; wa.x = pk2(acc[2 * pr][0], acc[2 * pr][1]); wa.y = pk2(acc[2 * pr][2], acc[2 * pr][3]);
            wb.x = pk2(acc[2 * pr + 1][0], acc[2 * pr + 1][1]); wb.y = pk2(acc[2 * pr + 1][2], acc[2 * pr + 1][3]);
            *(u32x4*)(op + (size_t)(32 * pr) * 128) = widen16(wa, wb); }
    }
#undef RKV_LOAD
}
__device__ __forceinline__ void ret_scan(bf16_t* kvb) {
    const int gt = blockIdx.x * 512 + otid(), nt = gridDim.x * 512;
    for (int idx = gt; idx < 16 * 8192; idx += nt) { const int bh = idx >> 13, e4 = idx & 8191, h = bh & 7;
        const float cd = exp2f(128.0f * ret_l2g(h));
        bf16_t* base = kvb + (size_t)bh * 64 * 32768 + e4 * 4;
        float s0 = 0.f, s1 = 0.f, s2 = 0.f, s3 = 0.f;
        for (int n0 = 0; n0 < 64; n0 += 8) { u32x2 w[8];
#pragma unroll
            for (int i = 0; i < 8; ++i) w[i] = *(const u32x2*)(base + (size_t)(n0 + i) * 32768);
#pragma unroll
            for (int i = 0; i < 8; ++i) { u32x2 o; o.x = pk2(s0, s1); o.y = pk2(s2, s3); *(u32x2*)(base + (size_t)(n0 + i) * 32768) = o;
                s0 = cd * s0 + bflo(w[i].x); s1 = cd * s1 + bfhi(w[i].x); s2 = cd * s2 + bflo(w[i].y); s3 = cd * s3 + bfhi(w[i].y); } }
    }
}
__device__ __forceinline__ void ret_out(LAS unsigned char* lds, bf16_t* proj, const bf16_t* kvb) {
    const int tid = otid(), wid = __builtin_amdgcn_readfirstlane(tid >> 6), lane = tid & 63, fr = lane & 15, g4 = lane >> 4;
    LAS unsigned char* Kimg = lds; LAS unsigned char* Vimg = lds + 34816;
    for (int unit = blockIdx.x; unit < 1024; unit += gridDim.x) {
        const int n = unit & 63, h = (unit >> 6) & 7, b = unit >> 9;
        const size_t t0 = (size_t)b * SEQ + 128 * n; const float l2g = ret_l2g(h);
        __syncthreads();
        { u32x4 sr[8];
#pragma unroll
        for (int i = 0; i < 8; ++i) { const int q = tid + 512 * i, row = q >> 4, pc = q & 15; sr[i] = *(const u32x4*)(kvb + (size_t)unit * 32768 + row * 128 + pc * 8); }
#pragma unroll
        for (int i = 0; i < 8; ++i) { const int q = tid + 512 * i, row = q >> 4, pc = q & 15; *(LAS u32x4*)(lds + row * 272 + pc * 16) = sr[i]; } }
        const size_t tq = t0 + 16 * wid + fr; const int iq = 16 * wid + fr;
        bf16x8 qf[4];
#pragma unroll
        for (int kk = 0; kk < 4; ++kk) qf[kk] = *(const bf16x8*)(proj + tq * NP1 + RQ0 + h * 128 + 32 * kk + 8 * g4);
        __syncthreads();
        f32x4 acc[16];
        const float qd = __builtin_amdgcn_exp2f((float)(iq + 1) * l2g);
#pragma unroll
        for (int cc = 0; cc < 16; ++cc) { acc[cc] = (f32x4){0.f, 0.f, 0.f, 0.f};
#pragma unroll
            for (int kk = 0; kk < 4; ++kk) { const bf16x8 a = *(const LAS bf16x8*)(lds + (16 * cc + fr) * 272 + (32 * kk + 8 * g4) * 2); acc[cc] = MFMA16(a, qf[kk], acc[cc]); }
            acc[cc] *= qd; }
        __syncthreads();
        { u32x4 kr[4], vr[4];
#pragma unroll
        for (int i = 0; i < 4; ++i) { const int q = tid + 512 * i, row = q >> 4, pc = q & 15; kr[i] = *(const u32x4*)(proj + (t0 + row) * NP1 + RK0 + h * 128 + pc * 8); }
#pragma unroll
        for (int i = 0; i < 4; ++i) { const int q = tid + 512 * i, row = q >> 5, pc = q & 31; vr[i] = *(const u32x4*)(proj + (t0 + row) * NP1 + RV0 + h * 256 + pc * 8); }
#pragma unroll
        for (int i = 0; i < 4; ++i) { const int q = tid + 512 * i, row = q >> 4, pc = q & 15; *(LAS u32x4*)(Kimg + row * 272 + pc * 16) = kr[i]; }
#pragma unroll
        for (int i = 0; i < 4; ++i) { const int q = tid + 512 * i, row = q >> 5, pc = q & 31; *(LAS u32x4*)(Vimg + row * 544 + pc * 16) = vr[i]; }
#pragma unroll
        for (int i = 0; i < 4; ++i) { const int q = tid + 512 * (i + 4), row = q >> 5, pc = q & 31; kr[i] = *(const u32x4*)(proj + (t0 + row) * NP1 + RV0 + h * 256 + pc * 8); }
#pragma unroll
        for (int i = 0; i < 4; ++i) { const int q = tid + 512 * (i + 4), row = q >> 5, pc = q & 31; *(LAS u32x4*)(Vimg + row * 544 + pc * 16) = kr[i]; } }
        __syncthreads();
        const int ntile = (wid | 1) + 1;
        bf16x8 pf[4];
#pragma unroll
        for (int pp = 0; pp < 4; ++pp) {
            if (2 * pp < ntile) {
                f32x4 s0 = (f32x4){0.f, 0.f, 0.f, 0.f}, s1 = (f32x4){0.f, 0.f, 0.f, 0.f};
#pragma unroll
                for (int kk = 0; kk < 4; ++kk) { const bf16x8 a0 = *(const LAS bf16x8*)(Kimg + (32 * pp + fr) * 272 + (32 * kk + 8 * g4) * 2);
                    const bf16x8 a1 = *(const LAS bf16x8*)(Kimg + (32 * pp + 16 + fr) * 272 + (32 * kk + 8 * g4) * 2);
                    s0 = MFMA16(a0, qf[kk], s0); s1 = MFMA16(a1, qf[kk], s1); }
#pragma unroll
                for (int e = 0; e < 4; ++e) { const int j0 = 32 * pp + 4 * g4 + e, j1 = j0 + 16;
                    s0[e] = (iq >= j0) ? s0[e] * __builtin_amdgcn_exp2f((float)(iq - j0) * l2g) : 0.f;
                    s1[e] = (iq >= j1) ? s1[e] * __builtin_amdgcn_exp2f((float)(iq - j1) * l2g) : 0.f; }
                pf[pp] = __builtin_bit_cast(bf16x8, pk8(s0, s1));
            } else pf[pp] = (bf16x8){0, 0, 0, 0, 0, 0, 0, 0};
        }
#pragma unroll
        for (int pp = 0; pp < 4; ++pp) {
            if (2 * pp < ntile) {
#pragma unroll
                for (int cc = 0; cc < 16; ++cc) { LAS unsigned char* a0 = Vimg + (32 * pp + 4 * g4 + (fr >> 2)) * 544 + 32 * cc + 8 * (fr & 3);
                    const bf16x8 a = tr2(a0, a0 + 16 * 544); acc[cc] = MFMA16(a, pf[pp], acc[cc]); }
            }
        }
        bf16_t* gp = proj + tq * NP1 + RG0 + h * 256 + 4 * g4;
        u32x2 gwv[16];
#pragma unroll
        for (int cc = 0; cc < 16; ++cc) gwv[cc] = *(const u32x2*)(gp + 16 * cc);
        float sm = 0.f;
#pragma unroll
        for (int cc = 0; cc < 16; ++cc) sm += (acc[cc][0] + acc[cc][1]) + (acc[cc][2] + acc[cc][3]);
        sm += __shfl_xor(sm, 16); sm += __shfl_xor(sm, 32);
        const float mean = sm * (1.0f / 256.0f); float vq = 0.f;
#pragma unroll
        for (int cc = 0; cc < 16; ++cc) { const f32x4 d = acc[cc] - mean; vq += (d[0] * d[0] + d[1] * d[1]) + (d[2] * d[2] + d[3] * d[3]); }
        vq += __shfl_xor(vq, 16); vq += __shfl_xor(vq, 32);
        const float rstd = rsqrtf(vq * (1.0f / 256.0f) + 1e-5f);
#pragma unroll
        for (int cc = 0; cc < 16; ++cc) { const u32x2 gw = gwv[cc];
            u32x2 w; w.x = pk2((acc[cc][0] - mean) * rstd * bflo(gw.x), (acc[cc][1] - mean) * rstd * bfhi(gw.x));
            w.y = pk2((acc[cc][2] - mean) * rstd * bflo(gw.y), (acc[cc][3] - mean) * rstd * bfhi(gw.y));
            *(u32x2*)(gp + 16 * cc) = w; }
    }
}

__device__ __forceinline__ GD gd_plain(const bf16_t* A, int lda, const bf16_t* Bt, int ldb, int M, int N, int K) {
    GD d; d.type = 3; d.A = A; d.Bt = Bt; d.lda = lda; d.ldb = ldb; d.M = M; d.N = N; d.K = K; d.nb = 1; d.nh = 1;
    d.sAb = d.sAh = d.sBb = d.sBh = d.sOb = d.sOh = 0; d.O = nullptr; d.ldc = 0; d.base = nullptr; d.scale = 1.f; d.act = 0; d.split = 1 << 30; d.base0 = 0; d.base1 = 0;
    d.gate = nullptr; d.add = 0; d.cs = nullptr; d.ss = nullptr; d.hb = nullptr; d.ssout = nullptr; d.crot = 0; d.zrow = 0; d.wgm = 4; return d;
}
constexpr int NSTEPS = 41;
#ifndef WGM_SWIGLU
#define WGM_SWIGLU 8
#endif
#ifndef WGM_PROJ
#define WGM_PROJ 4
#endif
#ifndef WGM_GATES
#define WGM_GATES 4
#endif
#define SYNC_CASES case 2: case 3: case 6: case 8: case 13: case 15: case 18: case 24: case 25: case 29: case 31: case 32: case 33: case 38: case 39:
__device__ __forceinline__ bool sync_after(int st) {
    switch (st) { SYNC_CASES return true; default: return false; }
}

__global__ void __launch_bounds__(512) mega(Params p) {
    extern __shared__ __attribute__((aligned(16))) unsigned char lds_raw[];
    LAS unsigned char* lds = (LAS unsigned char*)lds_raw;
    cg::grid_group grid = cg::this_grid();
    unsigned char* ws = p.ws;
    const float* x = p.in[0]; const float* mem = p.in[1]; const int* pos = (const int*)p.in[2];
    float* hbuf = p.out;
    bf16_t* hb = (bf16_t*)(ws + R1);
    bf16_t* proj = (bf16_t*)(ws + R0);
    bf16_t* hid = (bf16_t*)(ws + R0);
    bf16_t* W1IN = (bf16_t*)(ws + R2); bf16_t* W1OUT = (bf16_t*)(ws + R0 + 256 * MIB);
    bf16_t* WMIX1 = (bf16_t*)(ws + R2); float* CS = (float*)(ws + R2 + 64 * MIB);
    bf16_t* KVB = (bf16_t*)(ws + R2); bf16_t* WG = (bf16_t*)(ws + R2 + 64 * MIB); bf16_t* WA = (bf16_t*)(ws + R2 + 80 * MIB); bf16_t* WR = (bf16_t*)(ws + R2 + 84 * MIB);
    float* LSE = (float*)(ws + R2 + 92 * MIB);
    bf16_t* WOUT = (bf16_t*)(ws + R2); bf16_t* WQC = (bf16_t*)(ws + R2 + 8 * MIB); bf16_t* M2T = (bf16_t*)(ws + R2 + 40 * MIB); bf16_t* VWT = (bf16_t*)(ws + R2 + 48 * MIB); bf16_t* WKV = (bf16_t*)(ws + R2 + 16 * MIB); bf16_t* WO = (bf16_t*)(ws + R2 + 32 * MIB);
    bf16_t* QX = (bf16_t*)(ws + R0); float* SC = (float*)(ws + R0 + 64 * MIB); bf16_t* PB = (bf16_t*)(ws + R0 + 128 * MIB); bf16_t* OX = (bf16_t*)(ws + R0 + 160 * MIB);
    bf16_t* MEMN = (bf16_t*)(ws + MEMN_OFF); bf16_t* KX = (bf16_t*)(ws + KX_OFF); bf16_t* VX = (bf16_t*)(ws + VT_OFF);
    bf16_t* W2IN = (bf16_t*)(ws + R0 + 256 * MIB); bf16_t* W2OUT = (bf16_t*)(ws + R0 + 256 * MIB + 46137344);
    unsigned* BAR = (unsigned*)(ws + CTL0);
    float* SS1 = (float*)(ws + CTL0 + CTL_BAR_BYTES); float* SS2 = SS1 + T_TOK; float* SS3 = SS2 + T_TOK; float* SS0 = (float*)(ws + SS0_OFF);
    volatile LAS unsigned* xst = (volatile LAS unsigned*)(lds + 143360);
    if (threadIdx.x < 4) xst[threadIdx.x] = 0u;
    __syncthreads();
    XcdBarrier xbar = xcd_barrier_post(BAR, xst);
    if (p.lo < 0) grid.sync();

    for (int st = p.lo; st < p.hi; ++st) {
        bool isg = false; GD d = gd_plain(nullptr, 0, nullptr, 0, 0, 0, 0);
        switch (st) {
        case 0: conv_job(lds, p.in[4], 2 * DFF, DM, W1IN, 2 * DFF, 1, 0, p.in[3]); break;
        case 1: conv_job(lds, p.in[5], DM, DFF, W1OUT, DM, 0, 0); break;
        case 2: norm_rows(x, nullptr, hb, T_TOK, SS0); break;
        case 3: d = gd_plain(hb, DM, W1IN, DM, T_TOK, 2 * DFF, DM); d.type = 0; d.O = hid; d.ldc = DFF; d.ss = SS0; d.wgm = WGM_SWIGLU; isg = true; break;
        case 4: d = gd_plain(hid, DFF, W1OUT, DFF, T_TOK, DM, DFF); d.type = 1; d.O = hbuf; d.ldc = DM; d.base = x; d.scale = 0.5f; d.hb = hb; d.ssout = SS1; isg = true; break;
        case 5: conv_job(lds, p.in[7], 19456, DM, WMIX1, NP1, 2, 0, p.in[6]); break;
        case 6: cs_table(pos, CS); break;
        case 8: d = gd_plain(hb, DM, WMIX1, DM, T_TOK, NP1, DM); d.type = 2; d.O = proj; d.ldc = NP1; d.cs = CS; d.ss = SS1; d.wgm = WGM_PROJ; isg = true; break;
        case 9: dil_attn(lds, proj, LSE); break;
        case 10: ret_kv(lds, proj, KVB); break;
        case 11: conv_job(lds, p.in[7], 19456, DM, WG, 4096, 0, NP1, p.in[6]); break;
        case 12: conv_job(lds, p.in[8], DM, 1024, WA, DM, 0, 0); break;
        case 13: conv_job(lds, p.in[9], DM, DM, WR, DM, 0, 0); break;
        case 14: ret_scan(KVB); break;
        case 15: dil_combine(proj, LSE); break;
        case 17: ret_out(lds, proj, KVB); break;
        case 18: d = gd_plain(hb, DM, WG, DM, T_TOK, 4096, DM); d.O = proj; d.ldc = NP1; d.act = 1; d.split = 8; d.base0 = GA0; d.base1 = GB0; d.ss = SS1; d.wgm = WGM_GATES; isg = true; break;
        case 19: d = gd_plain(proj, NP1, WA, 1024, T_TOK, DM, 1024); d.type = 4; d.O = proj + MG0; d.ldc = NP1; d.gate = proj + GA0; d.add = 0; isg = true; break;
        case 20: d = gd_plain(proj + RG0, NP1, WR, DM, T_TOK, DM, DM); d.type = 4; d.O = proj + MG0; d.ldc = NP1; d.gate = proj + GB0; d.add = 1; isg = true; break;
        case 21: conv_job(lds, p.in[10], DM, DM, WOUT, DM, 0, 0); break;
        case 22: cast_job(p.in[13], p.in[11], WQC, DM, DM); break;
        case 23: conv_job(lds, p.in[14], 2 * DM, DM, WKV, 2 * DM, 0, 0); break;
        case 24: conv_job(lds, p.in[15], DM, DM, WO, DM, 0, 0); norm_rows(mem, p.in[12], MEMN, 512); break;
        case 25: d = gd_plain(proj + MG0, NP1, WOUT, DM, T_TOK, DM, DM); d.type = 1; d.O = hbuf; d.ldc = DM; d.base = hbuf; d.scale = 1.f; d.hb = hb; d.ssout = SS2; isg = true; break;
        case 26: d = gd_plain(MEMN, DM, WKV, DM, 512, DM, DM); d.O = KX; d.ldc = DM; isg = true; break;
        case 27: d = gd_plain(MEMN, DM, WKV + (size_t)DM * DM, DM, 512, DM, DM); d.O = VX; d.ldc = DM; d.crot = 16; isg = true; break;
        case 28: conv_job(lds, p.in[17], 2 * DFF, DM, W2IN, 2 * DFF, 1, 0, p.in[16], 32, (int)gridDim.x - 32); break;
        case 29: conv_job(lds, p.in[18], DM, DFF, W2OUT, DM, 0, 0, nullptr, 32, (int)gridDim.x - 32); break;
        case 30: d = gd_plain(KX, DM, WQC, DM, 256, DM, 512); d.nb = 2; d.nh = 4; d.sAb = 256L * DM; d.sAh = 512; d.sBb = 0; d.sBh = 512;
                 d.O = M2T; d.ldc = DM; d.sOb = 4L * 256 * DM; d.sOh = 256L * DM; d.scale = 0.04419417382415922f * LOG2E; isg = true; break;
        case 31: d = gd_plain(WO, DM, VX, DM, DM, 256, 512); d.nb = 2; d.nh = 4; d.sAb = 0; d.sAh = 512; d.sBb = 256L * DM; d.sBh = 512;
                 d.O = VWT; d.ldc = 1024; d.sOb = (long)DM * 1024; d.sOh = 256; d.crot = 64; isg = true; break;
        case 32: d = gd_plain(hb, DM, M2T, DM, SEQ, 256, DM); d.type = 5; d.nb = 2; d.nh = 4; d.sAb = (long)SEQ * DM; d.sAh = 0; d.sBb = 4L * 256 * DM; d.sBh = 256L * DM;
                 d.O = PB; d.ldc = 1024; d.sOb = (long)SEQ * 1024; d.sOh = 256; d.ss = SS2; d.zrow = SEQ; isg = true; break;
        case 33: d = gd_plain(PB, 1024, VWT, 1024, SEQ, DM, 1024); d.type = 1; d.nb = 2; d.nh = 1; d.sAb = (long)SEQ * 1024; d.sBb = (long)DM * 1024;
                 d.O = hbuf; d.ldc = DM; d.sOb = (long)SEQ * DM; d.base = hbuf; d.scale = 1.f; d.hb = hb; d.ssout = SS3; d.zrow = SEQ; isg = true; break;
        case 38: d = gd_plain(hb, DM, W2IN, DM, T_TOK, 2 * DFF, DM); d.type = 0; d.O = hid; d.ldc = DFF; d.ss = SS3; d.wgm = WGM_SWIGLU; isg = true; break;
        case 39: d = gd_plain(hid, DFF, W2OUT, DFF, T_TOK, DM, DFF); d.type = 1; d.O = hbuf; d.ldc = DM; d.base = hbuf; d.scale = 0.5f; isg = true; break;
        case 40: final_norm(hbuf, p.in[19], T_TOK); break;
        default: break;
        }
        if (isg) {
            __syncthreads();
            pg8::Gemm g{d.A, d.Bt, d.K, d.lda, d.ldb};
            pg8::Sched S; S.nM = d.M / 256; S.nN = d.N / 256; S.per = S.nM * S.nN; S.total = S.per * d.nb * d.nh; S.G = gridDim.x; S.c = (int)((blockIdx.x + gridDim.x - d.crot) % gridDim.x); S.nh = d.nh; S.WGM = d.wgm;
            S.tA = 256L * d.lda * 2; S.tB = 256L * d.ldb * 2; S.sAb = d.sAb * 2; S.sAh = d.sAh * 2; S.sBb = d.sBb * 2; S.sBh = d.sBh * 2;
            switch (d.type) {
            case 0: { EpiSwiglu E{(bf16_t*)d.O, d.ldc, d.ss}; pg8::gemm_phase(lds, g, S, E); } break;
            case 1: { EpiF32 E{(float*)d.O, d.ldc, d.base, d.scale, d.sOb, d.sOh, d.hb, d.ssout, d.zrow}; pg8::gemm_phase(lds, g, S, E); } break;
            case 2: { EpiProj E{(bf16_t*)d.O, d.ldc, d.cs, d.ss}; pg8::gemm_phase(lds, g, S, E); } break;
            case 3: { EpiAct E{(bf16_t*)d.O, d.ldc, d.scale, d.act, d.split, d.base0, d.base1, d.sOb, d.sOh, d.ss}; pg8::gemm_phase(lds, g, S, E); } break;
            case 5: { EpiSoftmax E{(bf16_t*)d.O, d.ldc, d.sOb, d.sOh, (LAS float*)(lds + 131072), d.ss, d.zrow}; pg8::gemm_phase(lds, g, S, E); } break;
            default: { EpiGate E{(bf16_t*)d.O, d.ldc, d.gate, d.add}; pg8::gemm_phase(lds, g, S, E); } break;
            }
            __syncthreads();
        }
        if (st + 1 < p.hi && sync_after(st)) xcd_barrier(xbar);
    }
}

extern "C" void kernel_launch(void* const* d_in, const int* in_sizes, int n_in, void* d_out, int out_size, void* d_ws, size_t ws_size, hipStream_t stream) {
    static int grid_blocks = 0;
    if (!grid_blocks) {
        if (n_in != 20 || ws_size < (size_t)WS_NEED) { fprintf(stderr, "kernel_launch: unexpected inputs (n_in %d, ws %zu need %ld)\n", n_in, ws_size, (long)WS_NEED); grid_blocks = -1; return; }
        int dev = 0, cus = 0, per_cu = 0;
        (void)hipGetDevice(&dev);
        (void)hipDeviceGetAttribute(&cus, hipDeviceAttributeMultiprocessorCount, dev);
        if (hipFuncSetAttribute((const void*)mega, hipFuncAttributeMaxDynamicSharedMemorySize, LDS_BYTES) != hipSuccess) { fprintf(stderr, "hipFuncSetAttribute failed\n"); grid_blocks = -1; return; }
        (void)hipOccupancyMaxActiveBlocksPerMultiprocessor(&per_cu, (const void*)mega, 512, LDS_BYTES);
        if (per_cu < 1) { fprintf(stderr, "occupancy query gave %d\n", per_cu); per_cu = 1; }
        grid_blocks = cus * 1;
    }
    if (grid_blocks < 0) return;
    (void)hipMemsetAsync((char*)d_ws + CTL0, 0, CTL_BYTES, stream);
    Params p{};
    for (int i = 0; i < 20; ++i) p.in[i] = (const float*)d_in[i];
    p.out = (float*)d_out; p.ws = (unsigned char*)d_ws;
#if ONE_LAUNCH
    p.lo = 0; p.hi = NSTEPS;
    void* args[] = {&p};
    hipError_t e = hipLaunchCooperativeKernel((const void*)mega, dim3(grid_blocks), dim3(512), args, LDS_BYTES, stream);
    if (e != hipSuccess) fprintf(stderr, "cooperative launch failed: %s (grid %d)\n", hipGetErrorString(e), grid_blocks);
#else
    int lo = 0;
    for (int st = 0; st < NSTEPS; ++st) {
        bool cut = (st == NSTEPS - 1);
        switch (st) { SYNC_CASES cut = true; break; default: break; }
        if (cut) { p.lo = lo; p.hi = st + 1; hipLaunchKernelGGL(mega, dim3(grid_blocks), dim3(512), LDS_BYTES, stream, p); lo = st + 1; }
    }
#endif
}
```

```cpp
#include <hip/hip_runtime.h>
#include <hip/hip_cooperative_groups.h>
#include <cstdio>
namespace cg = cooperative_groups;

#ifndef ONE_LAUNCH
#define ONE_LAUNCH 1
#endif

#define LAS __attribute__((address_space(3)))
typedef unsigned short bf16_t;
typedef short bf16x8 __attribute__((ext_vector_type(8)));
typedef short s16x4 __attribute__((ext_vector_type(4)));
typedef float f32x4 __attribute__((ext_vector_type(4)));
typedef float f32x2 __attribute__((ext_vector_type(2)));
typedef unsigned u32x4 __attribute__((ext_vector_type(4)));
typedef unsigned u32x2 __attribute__((ext_vector_type(2)));
typedef __bf16 bf16x2_t __attribute__((ext_vector_type(2)));

constexpr int T_TOK = 16384, DM = 2048, SEQ = 8192, DFF = 5632, NP1 = 15360;
constexpr long MIB = 1048576;
constexpr long R0 = 0, R1 = 503316480, R2 = R1 + 67108864, WS_END = R2 + 100663296;
constexpr int RQ0 = 9216, RK0 = 10240, RV0 = 11264, RG0 = 13312;
constexpr int GA0 = 1024, GB0 = 4096, MG0 = 7168;
constexpr float LOG2E = 1.4426950408889634f;
constexpr int LDS_BYTES = 143376;
constexpr long CTL0 = WS_END;
constexpr long CTL_BAR_BYTES = 16384;
constexpr long CTL_BYTES = CTL_BAR_BYTES + 3 * 65536;
constexpr long SS0_OFF = CTL0 + CTL_BYTES;
constexpr long MEMN_OFF = CTL0 + 1 * MIB, KX_OFF = MEMN_OFF + 2 * MIB, VT_OFF = KX_OFF + 2 * MIB, WS_NEED = VT_OFF + 2 * MIB;

struct Params {
    const float* in[20];
    float* out; unsigned char* ws;
    int lo, hi;
};

__device__ __forceinline__ unsigned pk2(float a, float b) { f32x2 v = {a, b}; return __builtin_bit_cast(unsigned, __builtin_convertvector(v, bf16x2_t)); }
__device__ __forceinline__ float bflo(unsigned w) { return __uint_as_float(w << 16); }
__device__ __forceinline__ float bfhi(unsigned w) { return __uint_as_float(w & 0xffff0000u); }
__device__ __forceinline__ float silu_f(float x) { return x * __builtin_amdgcn_rcpf(1.f + __builtin_amdgcn_exp2f(-LOG2E * x)); }
__device__ __forceinline__ float sigm_f(float x) { return __builtin_amdgcn_rcpf(1.f + __builtin_amdgcn_exp2f(-LOG2E * x)); }
__device__ __forceinline__ u32x4 pk8(const f32x4 a, const f32x4 b) { u32x4 w; w.x = pk2(a[0], a[1]); w.y = pk2(a[2], a[3]); w.z = pk2(b[0], b[1]); w.w = pk2(b[2], b[3]); return w; }
__device__ __forceinline__ float wave_sum(float v) { for (int o = 32; o >= 1; o >>= 1) v += __shfl_xor(v, o); return v; }
__device__ __forceinline__ float wave_max(float v) { for (int o = 32; o >= 1; o >>= 1) v = fmaxf(v, __shfl_xor(v, o)); return v; }
__device__ __forceinline__ bf16x8 tr2(LAS unsigned char* p0, LAS unsigned char* p1) {
    s16x4 a = __builtin_amdgcn_ds_read_tr16_b64_v4i16((LAS s16x4*)p0);
    s16x4 b = __builtin_amdgcn_ds_read_tr16_b64_v4i16((LAS s16x4*)p1);
    return __builtin_shufflevector(a, b, 0, 1, 2, 3, 4, 5, 6, 7);
}
__device__ __forceinline__ int otid() { int t = threadIdx.x; asm volatile("" : "+v"(t)); return t; }
#define XB_TMO      128
#define XB_XCNT(j)  (256  + 64 * (j))
#define XB_XSUB(j)  (1280 + 64 * (j))
#define XB_XGEN(j)  (2304 + 64 * (j))
#define XB_TOP      3328
#define XB_TOPGEN   3392
#define XB_SPIN_CAP (1u << 20)
__device__ __forceinline__ unsigned xb_ld(unsigned* p)              { return __hip_atomic_load(p, __ATOMIC_RELAXED, __HIP_MEMORY_SCOPE_AGENT); }
__device__ __forceinline__ unsigned xb_add(unsigned* p, unsigned v) { return __hip_atomic_fetch_add(p, v, __ATOMIC_RELAXED, __HIP_MEMORY_SCOPE_AGENT); }
__device__ __forceinline__ unsigned xb_xcc_id() { return (unsigned)__builtin_amdgcn_s_getreg((3 << 11) | 20) & 0xFu; }
#define XB_SPIN(cond, bar) do { unsigned _sp = 0; while (cond) { __builtin_amdgcn_s_sleep(1); \
    if ((++_sp & 255u) == 0u) { if (xb_ld(&(bar)[XB_TMO])) break; if (_sp > XB_SPIN_CAP) { atomicAdd(&(bar)[XB_TMO], 1u); break; } } } } while (0)
struct XcdBarrier { unsigned* bar; unsigned x; volatile LAS unsigned* st; };
__device__ __forceinline__ XcdBarrier xcd_barrier_post(unsigned* bar, volatile LAS unsigned* st) {
    XcdBarrier b; b.bar = bar; b.x = xb_xcc_id(); b.st = st;
    if (threadIdx.x == 0) (void)xb_add(&bar[XB_XCNT(b.x)], 1u);
    return b;
}
__device__ __forceinline__ void xcd_barrier_complete(unsigned* bar, unsigned x, unsigned& nloc, unsigned& nx) {
    const unsigned G = gridDim.x * gridDim.y * gridDim.z;
    unsigned sum, cnt, mine, sp = 0u;
    for (;;) {
        sum = 0u; cnt = 0u; mine = 0u;
        unsigned cv[16];
        { unsigned* cbase = &bar[XB_XCNT(0)];
          asm volatile("global_load_dword %0, %16, off sc1\n\t"
            "global_load_dword %1, %16, off offset:256 sc1\n\t"
            "global_load_dword %2, %16, off offset:512 sc1\n\t"
            "global_load_dword %3, %16, off offset:768 sc1\n\t"
            "global_load_dword %4, %16, off offset:1024 sc1\n\t"
            "global_load_dword %5, %16, off offset:1280 sc1\n\t"
            "global_load_dword %6, %16, off offset:1536 sc1\n\t"
            "global_load_dword %7, %16, off offset:1792 sc1\n\t"
            "global_load_dword %8, %16, off offset:2048 sc1\n\t"
            "global_load_dword %9, %16, off offset:2304 sc1\n\t"
            "global_load_dword %10, %16, off offset:2560 sc1\n\t"
            "global_load_dword %11, %16, off offset:2816 sc1\n\t"
            "global_load_dword %12, %16, off offset:3072 sc1\n\t"
            "global_load_dword %13, %16, off offset:3328 sc1\n\t"
            "global_load_dword %14, %16, off offset:3584 sc1\n\t"
            "global_load_dword %15, %16, off offset:3840 sc1\n\t"
            "s_waitcnt vmcnt(0)"
            : "=&v"(cv[0]), "=&v"(cv[1]), "=&v"(cv[2]), "=&v"(cv[3]), "=&v"(cv[4]), "=&v"(cv[5]), "=&v"(cv[6]), "=&v"(cv[7]), "=&v"(cv[8]), "=&v"(cv[9]), "=&v"(cv[10]), "=&v"(cv[11]), "=&v"(cv[12]), "=&v"(cv[13]), "=&v"(cv[14]), "=&v"(cv[15]) : "v"(cbase) : "memory"); }
#pragma unroll
        for (unsigned j = 0; j < 16; ++j) { const unsigned c = cv[j]; sum += c; cnt += (c > 0u) ? 1u : 0u; mine = (j == x) ? c : mine; }
        if (sum == G) break;
        __builtin_amdgcn_s_sleep(1);
        if ((++sp & 255u) == 0u) { if (xb_ld(&bar[XB_TMO])) break; if (sp > XB_SPIN_CAP) { atomicAdd(&bar[XB_TMO], 1u); break; } }
    }
    nloc = mine > 0u ? mine : 1u; nx = cnt > 0u ? cnt : 1u;
}
__device__ __forceinline__ void xcd_barrier(const XcdBarrier& b) {
    asm volatile("s_waitcnt vmcnt(0)" ::: "memory");
    __syncthreads();
    if (threadIdx.x == 0) {
        unsigned* bar = b.bar;
        __builtin_amdgcn_s_waitcnt(0);
        unsigned nloc = b.st[0], nx = b.st[1];
        if (nloc == 0u) { xcd_barrier_complete(bar, b.x, nloc, nx); b.st[0] = nloc; b.st[1] = nx; }
        const unsigned old = xb_add(&bar[XB_XSUB(b.x)], 1u);
        const unsigned gen = old / nloc;
        if (old + 1u == (gen + 1u) * nloc) {
            __builtin_amdgcn_fence(__ATOMIC_RELEASE, "agent");
            asm volatile("s_waitcnt vmcnt(0)" ::: "memory");
            const unsigned og = xb_add(&bar[XB_TOP], 1u);
            const unsigned tg = og / nx;
            if (og + 1u == (tg + 1u) * nx) xb_add(&bar[XB_TOPGEN], 1u);
            else XB_SPIN(xb_ld(&bar[XB_TOPGEN]) == tg, bar);
            __builtin_amdgcn_fence(__ATOMIC_ACQUIRE, "agent");
            xb_add(&bar[XB_XGEN(b.x)], 1u);
            asm volatile("s_waitcnt vmcnt(0)" ::: "memory");
        } else {
            XB_SPIN(xb_ld(&bar[XB_XGEN(b.x)]) == gen, bar);
            __builtin_amdgcn_fence(__ATOMIC_ACQUIRE, "agent");
            asm volatile("s_waitcnt vmcnt(0)" ::: "memory");
        }
    }
    __syncthreads();
}
__device__ __forceinline__ u32x4 widen16(u32x2 a, u32x2 b) {
    const auto r0 = __builtin_amdgcn_permlane16_swap(a.x, b.x, false, false);
    const auto r1 = __builtin_amdgcn_permlane16_swap(a.y, b.y, false, false);
    return (u32x4){r0[0], r1[0], r0[1], r1[1]};
}
#define MFMA16(a, b, c) __builtin_amdgcn_mfma_f32_16x16x32_bf16((a), (b), (c), 0, 0, 0)

struct Pre { float v[2]; };
__device__ __forceinline__ Pre pre_rows(const float* ss, int rowbase) { Pre p; p.v[0] = 1.0f; p.v[1] = 1.0f;
    if (ss) { const float* q = ss + rowbase;
        asm volatile("global_load_dword %0, %2, off\n\tglobal_load_dword %1, %2, off offset:512" : "=&v"(p.v[0]), "=&v"(p.v[1]) : "v"(q) : "memory"); }
    return p; }
__device__ __forceinline__ float pre_get(const Pre& p, int ai, int m, int fr) { return __shfl(p.v[ai], m * 16 + fr); }
__device__ __forceinline__ float rstd_pre(const float* ss, float v) { return ss ? rsqrtf(v * (1.0f / 2048.0f) + 1e-6f) : 1.0f; }
namespace pg8 {
constexpr int BM = 256, BK = 64, HALF = 128, HTB = HALF * BK * 2, NXCD = 8;
__device__ __forceinline__ int lds_byte(int r, int c) { const int st = (r >> 4) * 2 + (c >> 5), rr = r & 15, cc = c & 31, ob = rr * 64 + cc * 2; return st * 1024 + (ob ^ (((ob >> 9) & 1) << 5)); }
__device__ __forceinline__ void stage_rc(int b, int& R, int& C) { const int st = b / 1024, sb = b % 1024, swz = sb ^ (((sb >> 9) & 1) << 5); R = (st >> 1) * 16 + swz / 64; C = (st & 1) * 32 + (swz % 64) / 2; }
__device__ __forceinline__ int perm32(int rho) { const int n = rho >> 4, i = rho & 15; return 8 * (i >> 2) + 4 * n + (i & 3); }

struct Unit { int pm, pn, zb, zh; long ao, bo; };
struct Gemm { const bf16_t* A; const bf16_t* Bt; int K, lda, ldb; };
struct Sched {
    int nM, nN, per, total, G, c, nh, WGM; long tA, tB, sAb, sAh, sBb, sBh;
    __device__ __forceinline__ bool next(int i, Unit& u) const {
        const long L = (long)i * G + c; if (L >= total) return false;
        int z = 0, wgid = (int)L;
        if (total != per) { z = (int)(L / per); wgid = (int)(L - (long)z * per); }
        { const int q = per / NXCD, r = per % NXCD, xcd = wgid % NXCD, off = wgid / NXCD; wgid = (xcd < r ? xcd * (q + 1) : r * (q + 1) + (xcd - r) * q) + off; }
        const int nig = WGM * nN, gid = wgid / nig, rem = wgid - gid * nig, fm = gid * WGM, gsz = (nM - fm) < WGM ? (nM - fm) : WGM;
        if (gsz == WGM) { u.pm = fm + (rem & (WGM - 1)); u.pn = rem >> __builtin_ctz((unsigned)WGM); } else { u.pm = fm + (rem % gsz); u.pn = rem / gsz; }
        if (z == 0) { u.zb = 0; u.zh = 0; } else { u.zb = z / nh; u.zh = z - u.zb * nh; }
        u.ao = u.zb * sAb + u.zh * sAh + u.pm * tA; u.bo = u.zb * sBb + u.zh * sBh + u.pn * tB; return true;
    }
};

template <class Epi>
__device__ __forceinline__ void gemm_phase(LAS unsigned char* lds, const Gemm g, const Sched& S, const Epi& E) {
    const int tid = otid(), wid = __builtin_amdgcn_readfirstlane(tid >> 6), lane = tid & 63, wr = wid >> 2, wc = wid & 3, fr = lane & 15, fq = lane >> 4;
    const int nt = g.K / BK;
    unsigned voffA[2], voffB[2];
#pragma unroll
    for (int i = 0; i < 2; ++i) { int R, C; stage_rc(tid * 16 + i * 8192, R, C); const int Rb = Epi::PERM ? ((R & ~31) + perm32(R & 31)) : R;
        voffA[i] = (unsigned)(R * g.lda + C) * 2u; voffB[i] = (unsigned)(Rb * g.ldb + C) * 2u; }
    const size_t kstep = (size_t)(BK * 2);
    const size_t hstepA = (size_t)HALF * g.lda * 2, hstepB = (size_t)HALF * g.ldb * 2;
    const unsigned ldsw = (unsigned)wid * 1024u;
    const int aoff = lds_byte(wr * 64 + fr, fq * 8), boff = lds_byte(wc * 32 + fr, fq * 8);
#define PG8_SA(b, h) (((b) * 2 + (h)) * HTB)
#define PG8_SB(b, h) ((4 + (b) * 2 + (h)) * HTB)
#define PG8_STAGE(bufoff, gbase, voff) do { _Pragma("unroll") for (int _i = 0; _i < 2; ++_i) \
        __builtin_amdgcn_global_load_lds((const unsigned*)((const char*)(gbase) + (voff)[_i]), (LAS unsigned*)(lds + (bufoff) + ldsw + _i * 8192), 16, 0, 0); } while (0)
#define PG8_LDA(dst, b, h) do { _Pragma("unroll") for (int m = 0; m < 4; ++m) _Pragma("unroll") for (int k = 0; k < 2; ++k) dst[m][k] = *(const LAS bf16x8*)(lds + PG8_SA(b, h) + aoff + m * 2048 + k * 1024); } while (0)
#define PG8_LDB(dst, b, h) do { _Pragma("unroll") for (int n = 0; n < 2; ++n) _Pragma("unroll") for (int k = 0; k < 2; ++k) dst[n][k] = *(const LAS bf16x8*)(lds + PG8_SB(b, h) + boff + n * 2048 + k * 1024); } while (0)
#define PG8_MMA(ai, bj, At, Bt) do { __builtin_amdgcn_s_setprio(1); _Pragma("unroll") for (int m = 0; m < 4; ++m) _Pragma("unroll") for (int n = 0; n < 2; ++n) _Pragma("unroll") for (int k = 0; k < 2; ++k) \
        acc[ai][bj][m][n] = __builtin_amdgcn_mfma_f32_16x16x32_bf16(Bt[n][k], At[m][k], acc[ai][bj][m][n], 0, 0, 0); __builtin_amdgcn_s_setprio(0); } while (0)
#define PG8_WAIT_V(n) asm volatile("s_waitcnt vmcnt(" #n ")" ::: "memory")
#define PG8_WAIT_L(n) asm volatile("s_waitcnt lgkmcnt(" #n ")" ::: "memory")
#define PG8_BAR __builtin_amdgcn_s_barrier()
#define PG8_SCHED __builtin_amdgcn_sched_barrier(0)
    Unit cur, nxt; int ui = 0;
    if (!S.next(0, cur)) return;
    f32x4 acc[2][2][4][2];
#pragma unroll
    for (int a = 0; a < 2; ++a)
#pragma unroll
        for (int b = 0; b < 2; ++b)
#pragma unroll
            for (int m = 0; m < 4; ++m)
#pragma unroll
                for (int n = 0; n < 2; ++n) acc[a][b][m][n] = (f32x4){0.f, 0.f, 0.f, 0.f};
    bf16x8 At[4][2], B0[2][2], B1[2][2];
    const char* cA = (const char*)g.A + cur.ao; const char* cB = (const char*)g.Bt + cur.bo;
    PG8_STAGE(PG8_SB(0, 0), cB, voffB); PG8_STAGE(PG8_SA(0, 0), cA, voffA); PG8_STAGE(PG8_SB(0, 1), cB + hstepB, voffB); PG8_STAGE(PG8_SA(0, 1), cA + hstepA, voffA);
    if (wr == 1) PG8_BAR;
    PG8_WAIT_V(4); PG8_BAR;
    PG8_STAGE(PG8_SB(1, 0), cB + kstep, voffB); PG8_STAGE(PG8_SA(1, 0), cA + kstep, voffA); PG8_STAGE(PG8_SB(1, 1), cB + hstepB + kstep, voffB);
    PG8_WAIT_V(6); PG8_BAR;
    for (;;) {
        const Pre pre = E.prefetch(cur, wr, fr);
        const bool has_next = S.next(ui + 1, nxt);
        const char* nA = has_next ? (const char*)g.A + nxt.ao : cA; const char* nB = has_next ? (const char*)g.Bt + nxt.bo : cB;
        for (int t = 0; t < nt; t += 2) {
            const bool last = (t == nt - 2);
            const char* a1 = cA + (size_t)(t + 1) * kstep;
            const char* a2 = last ? nA : cA + (size_t)(t + 2) * kstep; const char* b2 = last ? nB : cB + (size_t)(t + 2) * kstep;
            const char* a3 = a2 + kstep; const char* b3 = b2 + kstep;
            PG8_LDB(B0, 0, 0); PG8_SCHED; PG8_LDA(At, 0, 0); PG8_STAGE(PG8_SA(1, 1), a1 + hstepA, voffA);
            PG8_WAIT_L(8); PG8_BAR; PG8_WAIT_L(0); PG8_MMA(0, 0, At, B0); PG8_BAR; PG8_SCHED;
            PG8_LDB(B1, 0, 1); PG8_STAGE(PG8_SB(0, 0), b2, voffB);
            PG8_BAR; PG8_WAIT_L(0); PG8_MMA(0, 1, At, B1); PG8_BAR;
            PG8_LDA(At, 0, 1); PG8_STAGE(PG8_SA(0, 0), a2, voffA);
            PG8_BAR; PG8_WAIT_L(0); PG8_MMA(1, 0, At, B0); PG8_BAR; PG8_SCHED;
            PG8_STAGE(PG8_SB(0, 1), b2 + hstepB, voffB);
            PG8_WAIT_V(6); PG8_BAR; PG8_MMA(1, 1, At, B1); PG8_BAR;
            PG8_LDB(B0, 1, 0); PG8_SCHED; PG8_LDA(At, 1, 0); PG8_STAGE(PG8_SA(0, 1), a2 + hstepA, voffA);
            PG8_WAIT_L(8); PG8_BAR; PG8_WAIT_L(0); PG8_MMA(0, 0, At, B0); PG8_BAR; PG8_SCHED;
            PG8_LDB(B1, 1, 1); PG8_STAGE(PG8_SB(1, 0), b3, voffB);
            PG8_BAR; PG8_WAIT_L(0); PG8_MMA(0, 1, At, B1); PG8_BAR;
            PG8_LDA(At, 1, 1); PG8_STAGE(PG8_SA(1, 0), a3, voffA);
            PG8_BAR; PG8_WAIT_L(0); PG8_MMA(1, 0, At, B0); PG8_BAR; PG8_SCHED;
            PG8_STAGE(PG8_SB(1, 1), b3 + hstepB, voffB);
            PG8_WAIT_V(6); PG8_BAR; PG8_MMA(1, 1, At, B1); PG8_BAR;
        }
        E(acc, cur, wr, wc, fr, fq, pre);
        if (!has_next) break;
#pragma unroll
        for (int a = 0; a < 2; ++a)
#pragma unroll
            for (int b = 0; b < 2; ++b)
#pragma unroll
                for (int m = 0; m < 4; ++m)
#pragma unroll
                    for (int n = 0; n < 2; ++n) acc[a][b][m][n] = (f32x4){0.f, 0.f, 0.f, 0.f};
        cur = nxt; cA = nA; cB = nB; ++ui;
    }
    PG8_WAIT_V(0);
    if (wr == 0) PG8_BAR;
    PG8_BAR;
#undef PG8_SA
#undef PG8_SB
#undef PG8_STAGE
#undef PG8_LDA
#undef PG8_LDB
#undef PG8_MMA
#undef PG8_WAIT_V
#undef PG8_WAIT_L
#undef PG8_BAR
#undef PG8_SCHED
}
}
using pg8::Unit;
typedef f32x4 Acc[2][2][4][2];

struct GD {
    int type;
    const bf16_t* A; const bf16_t* Bt; int lda, ldb, M, N, K;
    int nb, nh; long sAb, sAh, sBb, sBh, sOb, sOh;
    void* O; int ldc; const float* base; float scale; int act; int split, base0, base1;
    const bf16_t* gate; int add; const float* cs;
    const float* ss; bf16_t* hb; float* ssout; int crot; int zrow; int wgm;
};

__device__ __forceinline__ float rstd_of(const float* ss, int row) { return ss ? rsqrtf(ss[row] * (1.0f / DM) + 1e-6f) : 1.0f; }
struct EpiSwiglu { static constexpr bool PERM = true; bf16_t* O; int ldc; const float* ss;
    __device__ __forceinline__ Pre prefetch(const Unit& u, int wr, int fr) const { return pre_rows(ss, u.pm * 256 + wr * 64 + (int)(threadIdx.x & 63)); }
    __device__ __forceinline__ void operator()(const Acc& acc, const Unit& u, int wr, int wc, int fr, int fq, const Pre& pre) const {
        const int row0 = u.pm * 256 + wr * 64 + fr, col0 = u.pn * 128 + wc * 32 + 8 * fq;
        float rsq[2][4];
#pragma unroll
        for (int ai = 0; ai < 2; ++ai)
#pragma unroll
            for (int m = 0; m < 4; ++m) rsq[ai][m] = rstd_pre(ss, pre_get(pre, ai, m, fr));
#pragma unroll
        for (int ai = 0; ai < 2; ++ai)
#pragma unroll
            for (int m = 0; m < 4; ++m) {
                f32x4 v0, v1; const float rs = rsq[ai][m];
#pragma unroll
                for (int e = 0; e < 4; ++e) { v0[e] = silu_f(acc[ai][0][m][0][e] * rs) * (acc[ai][1][m][0][e] * rs); v1[e] = silu_f(acc[ai][0][m][1][e] * rs) * (acc[ai][1][m][1][e] * rs); }
                *(u32x4*)(O + (size_t)(row0 + ai * 128 + m * 16) * ldc + col0) = pk8(v0, v1);
            }
    }
};
struct EpiF32 { static constexpr bool PERM = true; float* O; int ldc; const float* base; float scale; long sOb, sOh; bf16_t* hb; float* ssout; int zrow;
    __device__ __forceinline__ Pre prefetch(const Unit&, int, int) const { Pre p; p.v[0] = 1.0f; p.v[1] = 1.0f; return p; }
    __device__ __forceinline__ void operator()(const Acc& acc, const Unit& u, int wr, int wc, int fr, int fq, const Pre& pre) const {
        const int row0 = u.pm * 256 + wr * 64 + fr, col0 = u.pn * 256 + wc * 32 + 8 * fq;
        const size_t zo = (size_t)(u.zb * sOb + u.zh * sOh);
#pragma unroll
        for (int ai = 0; ai < 2; ++ai) {
            f32x4 bv[4][2][2];
            if (base) {
#pragma unroll
                for (int m = 0; m < 4; ++m) { const size_t off = zo + (size_t)(row0 + ai * 128 + m * 16) * ldc + col0;
#pragma unroll
                    for (int bj = 0; bj < 2; ++bj)
#pragma unroll
                        for (int n = 0; n < 2; ++n) bv[m][bj][n] = *(const f32x4*)(base + off + bj * 128 + n * 4); }
            }
#pragma unroll
            for (int m = 0; m < 4; ++m) { const size_t off = zo + (size_t)(row0 + ai * 128 + m * 16) * ldc + col0; float sq = 0.f;
#pragma unroll
                for (int bj = 0; bj < 2; ++bj) { f32x4 v0 = acc[ai][bj][m][0] * scale, v1 = acc[ai][bj][m][1] * scale;
                    if (base) { v0 += bv[m][bj][0]; v1 += bv[m][bj][1]; }
                    *(f32x4*)(O + off + bj * 128) = v0; *(f32x4*)(O + off + bj * 128 + 4) = v1;
                    if (hb) { *(u32x4*)(hb + off + bj * 128) = pk8(v0, v1);
                        sq += (v0[0] * v0[0] + v0[1] * v0[1]) + (v0[2] * v0[2] + v0[3] * v0[3]) + (v1[0] * v1[0] + v1[1] * v1[1]) + (v1[2] * v1[2] + v1[3] * v1[3]); } }
                if (ssout) { sq += __shfl_xor(sq, 16); sq += __shfl_xor(sq, 32); if (fq == 0) __hip_atomic_fetch_add(ssout + u.zb * zrow + row0 + ai * 128 + m * 16, sq, __ATOMIC_RELAXED, __HIP_MEMORY_SCOPE_AGENT); } }
            asm volatile("" ::: "memory");
        }
    }
};
struct EpiProj { static constexpr bool PERM = true; bf16_t* O; int ldc; const float* cs; const float* ss;
    __device__ __forceinline__ Pre prefetch(const Unit& u, int wr, int fr) const { return pre_rows(ss, u.pm * 256 + wr * 64 + (int)(threadIdx.x & 63)); }
    __device__ __forceinline__ void operator()(const Acc& acc, const Unit& u, int wr, int wc, int fr, int fq, const Pre& pre) const {
        const int tile = u.pn; int mode = 0; float scale0 = 1.f;
        if (tile < 36) { const int tg = tile % 12; if (tg < 4) { mode = 1; scale0 = 0.08838834764831845f * LOG2E; } else if (tg < 8) mode = 1; }
        else if (tile < 40) mode = 1;
        else if (tile < 44) { mode = 1; scale0 = 0.08838834764831845f; }
        else if (tile >= 52) mode = 2;
        const int row0 = u.pm * 256 + wr * 64 + fr;
        float rsq[2][4];
#pragma unroll
        for (int ai = 0; ai < 2; ++ai)
#pragma unroll
            for (int m = 0; m < 4; ++m) rsq[ai][m] = rstd_pre(ss, pre_get(pre, ai, m, fr));
        if (mode == 1) {
            const int head2 = wc >> 1, i0 = 32 * (wc & 1) + 8 * fq;
#pragma unroll
            for (int ai = 0; ai < 2; ++ai) {
                f32x4 cv[4][4]; float rsv[4];
#pragma unroll
                for (int m = 0; m < 4; ++m) { const int row = row0 + ai * 128 + m * 16; rsv[m] = rsq[ai][m];
                    const f32x4* cp = (const f32x4*)(cs + (size_t)row * 128 + i0 * 2); cv[m][0] = cp[0]; cv[m][1] = cp[1]; cv[m][2] = cp[2]; cv[m][3] = cp[3]; }
#pragma unroll
                for (int m = 0; m < 4; ++m) { const int row = row0 + ai * 128 + m * 16; const float scale = scale0 * rsv[m];
                    const f32x4 c0 = cv[m][0], c1 = cv[m][1], c2 = cv[m][2], c3 = cv[m][3];
                    const f32x4 xa = acc[ai][0][m][0], xb = acc[ai][0][m][1], ya = acc[ai][1][m][0], yb = acc[ai][1][m][1];
                    f32x4 o1a, o1b, o2a, o2b;
                    o1a[0] = (xa[0] * c0[0] - ya[0] * c0[1]) * scale; o2a[0] = (ya[0] * c0[0] + xa[0] * c0[1]) * scale;
                    o1a[1] = (xa[1] * c0[2] - ya[1] * c0[3]) * scale; o2a[1] = (ya[1] * c0[2] + xa[1] * c0[3]) * scale;
                    o1a[2] = (xa[2] * c1[0] - ya[2] * c1[1]) * scale; o2a[2] = (ya[2] * c1[0] + xa[2] * c1[1]) * scale;
                    o1a[3] = (xa[3] * c1[2] - ya[3] * c1[3]) * scale; o2a[3] = (ya[3] * c1[2] + xa[3] * c1[3]) * scale;
                    o1b[0] = (xb[0] * c2[0] - yb[0] * c2[1]) * scale; o2b[0] = (yb[0] * c2[0] + xb[0] * c2[1]) * scale;
                    o1b[1] = (xb[1] * c2[2] - yb[1] * c2[3]) * scale; o2b[1] = (yb[1] * c2[2] + xb[1] * c2[3]) * scale;
                    o1b[2] = (xb[2] * c3[0] - yb[2] * c3[1]) * scale; o2b[2] = (yb[2] * c3[0] + xb[2] * c3[1]) * scale;
                    o1b[3] = (xb[3] * c3[2] - yb[3] * c3[3]) * scale; o2b[3] = (yb[3] * c3[2] + xb[3] * c3[3]) * scale;
                    bf16_t* rp = O + (size_t)row * ldc + tile * 256 + head2 * 128 + i0;
                    *(u32x4*)rp = pk8(o1a, o1b); *(u32x4*)(rp + 64) = pk8(o2a, o2b); }
                asm volatile("" ::: "memory"); }
        } else {
            const int col0 = tile * 256 + wc * 32 + 8 * fq;
#pragma unroll
            for (int ai = 0; ai < 2; ++ai)
#pragma unroll
                for (int m = 0; m < 4; ++m) { const float rs = rsq[ai][m];
#pragma unroll
                    for (int bj = 0; bj < 2; ++bj) { f32x4 v0 = acc[ai][bj][m][0] * rs, v1 = acc[ai][bj][m][1] * rs;
                        if (mode == 2) {
#pragma unroll
                            for (int e = 0; e < 4; ++e) { v0[e] = silu_f(v0[e]); v1[e] = silu_f(v1[e]); } }
                        *(u32x4*)(O + (size_t)(row0 + ai * 128 + m * 16) * ldc + col0 + bj * 128) = pk8(v0, v1); } }
        }
    }
};
struct EpiAct { static constexpr bool PERM = true; bf16_t* O; int ldc; float scale; int act; int split, base0, base1; long sOb, sOh; const float* ss;
    __device__ __forceinline__ Pre prefetch(const Unit& u, int wr, int fr) const { return pre_rows(ss, u.pm * 256 + wr * 64 + (int)(threadIdx.x & 63)); }
    __device__ __forceinline__ void operator()(const Acc& acc, const Unit& u, int wr, int wc, int fr, int fq, const Pre& pre) const {
        const int colt = (u.pn < split) ? base0 + u.pn * 256 : base1 + (u.pn - split) * 256;
        const int row0 = u.pm * 256 + wr * 64 + fr, col0 = colt + wc * 32 + 8 * fq;
        bf16_t* Oz = O + (size_t)(u.zb * sOb + u.zh * sOh);
        float rsq[2][4];
#pragma unroll
        for (int ai = 0; ai < 2; ++ai)
#pragma unroll
            for (int m = 0; m < 4; ++m) rsq[ai][m] = rstd_pre(ss, pre_get(pre, ai, m, fr));
#pragma unroll
        for (int ai = 0; ai < 2; ++ai)
#pragma unroll
            for (int m = 0; m < 4; ++m) { const float rs = scale * rsq[ai][m];
#pragma unroll
                for (int bj = 0; bj < 2; ++bj) { f32x4 v0 = acc[ai][bj][m][0] * rs, v1 = acc[ai][bj][m][1] * rs;
                    if (act == 1) {
#pragma unroll
                        for (int e = 0; e < 4; ++e) { v0[e] = sigm_f(v0[e]); v1[e] = sigm_f(v1[e]); } }
                    *(u32x4*)(Oz + (size_t)(row0 + ai * 128 + m * 16) * ldc + col0 + bj * 128) = pk8(v0, v1); } }
    }
};
struct EpiSoftmax { static constexpr bool PERM = true; bf16_t* O; int ldc; long sOb, sOh; LAS float* X; const float* ss; int zrow;
    __device__ __forceinline__ Pre prefetch(const Unit& u, int wr, int fr) const { return pre_rows(ss, u.zb * zrow + u.pm * 256 + wr * 64 + (int)(threadIdx.x & 63)); }
    __device__ __forceinline__ void operator()(const Acc& acc, const Unit& u, int wr, int wc, int fr, int fq, const Pre& pre) const {
        const int row0 = u.pm * 256 + wr * 64 + fr, col0 = wc * 32 + 8 * fq;
        bf16_t* Oz = O + (size_t)(u.zb * sOb + u.zh * sOh);
        float rs[2][4];
#pragma unroll
        for (int ai = 0; ai < 2; ++ai)
#pragma unroll
            for (int m = 0; m < 4; ++m) rs[ai][m] = rstd_pre(ss, pre_get(pre, ai, m, fr));
#pragma unroll
        for (int ai = 0; ai < 2; ++ai)
#pragma unroll
            for (int m = 0; m < 4; ++m) { float mx = -INFINITY;
#pragma unroll
                for (int bj = 0; bj < 2; ++bj)
#pragma unroll
                    for (int n = 0; n < 2; ++n) { const f32x4 a = acc[ai][bj][m][n]; mx = fmaxf(mx, fmaxf(fmaxf(a[0], a[1]), fmaxf(a[2], a[3]))); }
                mx *= rs[ai][m];
                mx = fmaxf(mx, __shfl_xor(mx, 16)); mx = fmaxf(mx, __shfl_xor(mx, 32));
                if (fq == 0) X[(ai * 128 + wr * 64 + m * 16 + fr) * 4 + wc] = mx; }
        asm volatile("s_waitcnt lgkmcnt(0)" ::: "memory"); __builtin_amdgcn_s_barrier(); asm volatile("" ::: "memory");
        float rmx[2][4];
#pragma unroll
        for (int ai = 0; ai < 2; ++ai)
#pragma unroll
            for (int m = 0; m < 4; ++m) { const f32x4 q = *(const LAS f32x4*)(X + (ai * 128 + wr * 64 + m * 16 + fr) * 4);
                const float mx = fmaxf(fmaxf(q[0], q[1]), fmaxf(q[2], q[3])); rmx[ai][m] = mx; float sm = 0.f; const float r = rs[ai][m];
#pragma unroll
                for (int bj = 0; bj < 2; ++bj)
#pragma unroll
                    for (int n = 0; n < 2; ++n)
#pragma unroll
                        for (int e = 0; e < 4; ++e) sm += __builtin_amdgcn_exp2f(acc[ai][bj][m][n][e] * r - mx);
                sm += __shfl_xor(sm, 16); sm += __shfl_xor(sm, 32);
                if (fq == 0) X[1024 + (ai * 128 + wr * 64 + m * 16 + fr) * 4 + wc] = sm; }
        asm volatile("s_waitcnt lgkmcnt(0)" ::: "memory"); __builtin_amdgcn_s_barrier(); asm volatile("" ::: "memory");
#pragma unroll
        for (int ai = 0; ai < 2; ++ai)
#pragma unroll
            for (int m = 0; m < 4; ++m) { const f32x4 q = *(const LAS f32x4*)(X + 1024 + (ai * 128 + wr * 64 + m * 16 + fr) * 4);
                const float inv = 1.0f / ((q[0] + q[1]) + (q[2] + q[3])); const float mx = rmx[ai][m], r = rs[ai][m];
#pragma unroll
                for (int bj = 0; bj < 2; ++bj) { f32x4 v0, v1;
#pragma unroll
                    for (int e = 0; e < 4; ++e) { v0[e] = __builtin_amdgcn_exp2f(acc[ai][bj][m][0][e] * r - mx) * inv; v1[e] = __builtin_amdgcn_exp2f(acc[ai][bj][m][1][e] * r - mx) * inv; }
                    *(u32x4*)(Oz + (size_t)(row0 + ai * 128 + m * 16) * ldc + col0 + bj * 128) = pk8(v0, v1); } }
    }
};
struct EpiGate { static constexpr bool PERM = true; bf16_t* O; int ldc; const bf16_t* gate; int add;
    __device__ __forceinline__ Pre prefetch(const Unit&, int, int) const { Pre p; p.v[0] = 1.0f; p.v[1] = 1.0f; return p; }
    __device__ __forceinline__ void operator()(const Acc& acc, const Unit& u, int wr, int wc, int fr, int fq, const Pre& pre) const {
        const int row0 = u.pm * 256 + wr * 64 + fr, col0 = u.pn * 256 + wc * 32 + 8 * fq;
#pragma unroll
        for (int ai = 0; ai < 2; ++ai) {
            u32x4 gw[4][2], pw[4][2];
#pragma unroll
            for (int m = 0; m < 4; ++m)
#pragma unroll
                for (int bj = 0; bj < 2; ++bj) { const size_t off = (size_t)(row0 + ai * 128 + m * 16) * ldc + col0 + bj * 128;
                    gw[m][bj] = *(const u32x4*)(gate + off); if (add) pw[m][bj] = *(const u32x4*)(O + off); }
#pragma unroll
            for (int m = 0; m < 4; ++m)
#pragma unroll
                for (int bj = 0; bj < 2; ++bj) { const size_t off = (size_t)(row0 + ai * 128 + m * 16) * ldc + col0 + bj * 128;
                    const u32x4 g = gw[m][bj];
                    f32x4 v0 = acc[ai][bj][m][0], v1 = acc[ai][bj][m][1];
                    v0[0] *= bflo(g.x); v0[1] *= bfhi(g.x); v0[2] *= bflo(g.y); v0[3] *= bfhi(g.y);
                    v1[0] *= bflo(g.z); v1[1] *= bfhi(g.z); v1[2] *= bflo(g.w); v1[3] *= bfhi(g.w);
                    if (add) { const u32x4 q = pw[m][bj];
                        v0[0] += bflo(q.x); v0[1] += bfhi(q.x); v0[2] += bflo(q.y); v0[3] += bfhi(q.y);
                        v1[0] += bflo(q.z); v1[1] += bfhi(q.z); v1[2] += bflo(q.w); v1[3] += bfhi(q.w); }
                    *(u32x4*)(O + off) = pk8(v0, v1); }
            asm volatile("" ::: "memory");
        }
    }
};

__device__ __forceinline__ int srccol64(int mode, int p0, int n0) {
    if (mode == 0) return p0 + n0;
    const int tile = n0 >> 8, rem = n0 & 255, bj = rem >> 7, j = rem & 127;
    if (mode == 1) return bj * DFF + tile * 128 + j;
    bool rope;
    if (tile < 36) rope = (tile % 12) < 8; else rope = tile < 44;
    if (!rope) return n0;
    return tile * 256 + (j >> 6) * 128 + bj * 64 + (j & 63);
}
__device__ __forceinline__ void conv_job(LAS unsigned char* lds, const float* src, int ld, int K, bf16_t* dst, int nrows, int mode, int p0, const float* gain = nullptr, int rank0 = 0, int nranks = 0) {
    const int tid = otid(), c4 = tid & 31, kr = tid >> 5;
    const int nNt = nrows >> 7, nKt = K >> 7, nu = nNt * nKt;
    if (nranks == 0) nranks = gridDim.x;
    int u = (int)blockIdx.x - rank0; if (u < 0 || u >= nu) return;
    f32x4 va[8], vb[8], gq[2];
#define CONV_LOAD(dstv, uu) do { const int n_ = ((uu) % nNt) * 128, k_ = ((uu) / nNt) * 128; \
        const float* sp_ = src + (size_t)(k_ + kr * 8) * ld + srccol64(mode, p0, n_ + (c4 >> 4) * 64) + (c4 & 15) * 4; \
        _Pragma("unroll") for (int it = 0; it < 8; ++it) dstv[it] = __builtin_nontemporal_load((const f32x4*)(sp_ + (size_t)it * ld)); } while (0)
#define CONV_GAIN(uu) do { if (gain) { const int kg_ = ((uu) / nNt) * 128 + kr * 8; gq[0] = *(const f32x4*)(gain + kg_); gq[1] = *(const f32x4*)(gain + kg_ + 4); } } while (0)
#define CONV_EMIT(v, uu, ugain, unext) do { const int n0 = ((uu) % nNt) * 128, k0 = ((uu) / nNt) * 128; \
        if (gain) { _Pragma("unroll") for (int it = 0; it < 4; ++it) { v[it] *= gq[0][it]; v[it + 4] *= gq[1][it]; } } \
        asm volatile("s_waitcnt lgkmcnt(0)" ::: "memory"); __builtin_amdgcn_s_barrier(); asm volatile("" ::: "memory");     \
        _Pragma("unroll") for (int e = 0; e < 4; ++e) { \
            u32x4 w; w.x = pk2(v[0][e], v[1][e]); w.y = pk2(v[2][e], v[3][e]); w.z = pk2(v[4][e], v[5][e]); w.w = pk2(v[6][e], v[7][e]); \
            *(LAS u32x4*)(lds + (c4 + 32 * e) * 272 + kr * 16) = w; } \
        if ((ugain) < nu) CONV_GAIN(ugain); \
        if ((unext) < nu) CONV_LOAD(v, unext); \
        asm volatile("s_waitcnt lgkmcnt(0)" ::: "memory"); __builtin_amdgcn_s_barrier(); asm volatile("" ::: "memory"); \
        _Pragma("unroll") for (int i = 0; i < 4; ++i) { const int p = tid + 512 * i, n = p >> 4, pc = p & 15; \
            const u32x4 w = *(const LAS u32x4*)(lds + ((n >> 2) + 32 * (n & 3)) * 272 + pc * 16); \
            *(u32x4*)(dst + (size_t)(n0 + n) * K + k0 + pc * 8) = w; } } while (0)
    CONV_LOAD(va, u);
    CONV_GAIN(u);
    if (u + nranks < nu) CONV_LOAD(vb, u + nranks);
    for (; u < nu; u += 2 * nranks) {
        CONV_EMIT(va, u, u + nranks, u + 2 * nranks);
        if (u + nranks < nu) CONV_EMIT(vb, u + nranks, u + 2 * nranks, u + 3 * nranks);
    }
#undef CONV_LOAD
#undef CONV_EMIT
#undef CONV_GAIN
}
__device__ __forceinline__ void cast_job(const float* src, const float* gain, bf16_t* dst, int rows, int cols) {
    const int gt = blockIdx.x * 512 + otid(), nt = gridDim.x * 512, per = cols >> 3;
    for (int idx = gt; idx < rows * per; idx += nt) { const int k = idx / per, c = (idx % per) * 8; const float g = gain[k];
        const f32x4 a = __builtin_nontemporal_load((const f32x4*)(src + (size_t)k * cols + c)), b = __builtin_nontemporal_load((const f32x4*)(src + (size_t)k * cols + c + 4));
        *(u32x4*)(dst + (size_t)k * cols + c) = pk8(a * g, b * g); }
}
__device__ __forceinline__ void norm_rows(const float* src, const float* gain, bf16_t* dst, int nrows, float* ssq = nullptr) {
    const int tid = otid(), lane = tid & 63, gw = blockIdx.x * 8 + (tid >> 6), nw = gridDim.x * 8;
    for (int row = gw; row < nrows; row += nw) {
        const f32x4* p = (const f32x4*)(src + (size_t)row * DM); f32x4 v[8]; float ss = 0.f;
#pragma unroll
        for (int i = 0; i < 8; ++i) { v[i] = __builtin_nontemporal_load(p + i * 64 + lane); ss += v[i][0] * v[i][0] + v[i][1] * v[i][1] + v[i][2] * v[i][2] + v[i][3] * v[i][3]; }
        ss = wave_sum(ss); const float r = gain ? rsqrtf(ss * (1.0f / DM) + 1e-6f) : 1.0f;
        if (!gain && lane == 0) ssq[row] = ss;
#pragma unroll
        for (int i = 0; i < 8; ++i) { const f32x4 gn = gain ? ((const f32x4*)gain)[i * 64 + lane] : (f32x4){1.f, 1.f, 1.f, 1.f}; u32x2 w; w.x = pk2(v[i][0] * r * gn[0], v[i][1] * r * gn[1]); w.y = pk2(v[i][2] * r * gn[2], v[i][3] * r * gn[3]);
            *(u32x2*)(dst + (size_t)row * DM + (i * 64 + lane) * 4) = w; }
    }
}
__device__ __forceinline__ void final_norm(float* h, const float* gain, int nrows) {
    const int tid = otid(), lane = tid & 63, gw = blockIdx.x * 8 + (tid >> 6), nw = gridDim.x * 8;
    f32x4 gn[8];
#pragma unroll
    for (int i = 0; i < 8; ++i) gn[i] = ((const f32x4*)gain)[i * 64 + lane];
    for (int row = gw; row < nrows; row += nw) {
        f32x4* p = (f32x4*)(h + (size_t)row * DM); f32x4 v[8]; float ss = 0.f;
#pragma unroll
        for (int i = 0; i < 8; ++i) { v[i] = p[i * 64 + lane]; ss += v[i][0] * v[i][0] + v[i][1] * v[i][1] + v[i][2] * v[i][2] + v[i][3] * v[i][3]; }
        ss = wave_sum(ss); const float r = rsqrtf(ss * (1.0f / DM) + 1e-6f);
#pragma unroll
        for (int i = 0; i < 8; ++i) __builtin_nontemporal_store(v[i] * r * gn[i], p + i * 64 + lane);
    }
}
__device__ __forceinline__ void cs_table(const int* pos, float* cs) {
    const int gt = blockIdx.x * 512 + otid(), nt = gridDim.x * 512;
    const bool inv_const = (nt & 63) == 0;
    float inv = powf(10000.0f, -(float)(gt & 63) * (1.0f / 64.0f));
    for (int e = gt; e < T_TOK * 64; e += nt) { const int t = e >> 6, i = e & 63;
        if (!inv_const) inv = powf(10000.0f, -(float)i * (1.0f / 64.0f));
        const float ang = (float)pos[t] * inv;
        double rev = (double)ang * 0.15915494309189535; rev -= rint(rev); const float fr = (float)rev;
        f32x2 o; o.x = __builtin_amdgcn_cosf(fr); o.y = __builtin_amdgcn_sinf(fr); *(f32x2*)(cs + (size_t)e * 2) = o; }
}
__device__ __forceinline__ void softmax_rows(const float* sc, bf16_t* P, int nrows) {
    const int tid = otid(), lane = tid & 63, gw = blockIdx.x * 8 + (tid >> 6), nw = gridDim.x * 8;
    for (int row = gw; row < nrows; row += nw) {
        const f32x4 v = *(const f32x4*)(sc + (size_t)row * 256 + lane * 4);
        const float mx = wave_max(fmaxf(fmaxf(v[0], v[1]), fmaxf(v[2], v[3])));
        f32x4 p; p[0] = __builtin_amdgcn_exp2f(v[0] - mx); p[1] = __builtin_amdgcn_exp2f(v[1] - mx); p[2] = __builtin_amdgcn_exp2f(v[2] - mx); p[3] = __builtin_amdgcn_exp2f(v[3] - mx);
        const float inv = 1.0f / wave_sum(p[0] + p[1] + p[2] + p[3]);
        u32x2 w; w.x = pk2(p[0] * inv, p[1] * inv); w.y = pk2(p[2] * inv, p[3] * inv);
        *(u32x2*)(P + (size_t)row * 256 + lane * 4) = w;
    }
}

__device__ __forceinline__ void dil_attn(LAS unsigned char* lds, bf16_t* proj, float* lse2) {
    const int tid = otid(), wid = __builtin_amdgcn_readfirstlane(tid >> 6), lane = tid & 63, fr = lane & 15, g4 = lane >> 4;
    LAS unsigned char* Kimg = lds; LAS unsigned char* Vimg = lds + 69632;
    u32x4 kr[8], vr[8]; bf16x8 qn[4];
#define DIL_DECODE(unit_) const int jc = (unit_) & 63; int rest = (unit_) >> 6; const int h = rest & 7; rest >>= 3; const int g = rest % 3, b = rest / 3; \
        const int r = 1 << (2 * g), nb = 64 >> (2 * g), c = jc / nb, j = jc % nb; const int qcol = g * 3072 + h * 128; const size_t tb0 = (size_t)b * SEQ + c;
#define DIL_LOAD(unit_) do { DIL_DECODE(unit_) \
        _Pragma("unroll") for (int i = 0; i < 8; ++i) { const int q = tid + 512 * i, row = q >> 4, pc = q & 15; \
            const int pk = (j == 0 && row < 128) ? row : 128 * (j - 1) + row; \
            const bf16_t* rp = proj + (tb0 + (size_t)pk * r) * NP1 + qcol + pc * 8; \
            kr[i] = *(const u32x4*)(rp + 1024); vr[i] = *(const u32x4*)(rp + 2048); } \
        const size_t tq_ = tb0 + (size_t)(128 * j + 16 * wid + fr) * r; \
        _Pragma("unroll") for (int kk = 0; kk < 4; ++kk) qn[kk] = *(const bf16x8*)(proj + tq_ * NP1 + qcol + 32 * kk + 8 * g4); } while (0)
    int unit = blockIdx.x;
    if (unit < 3072) DIL_LOAD(unit);
    for (; unit < 3072; unit += gridDim.x) {
        DIL_DECODE(unit)
        const size_t tq = tb0 + (size_t)(128 * j + 16 * wid + fr) * r;
        __syncthreads();
#pragma unroll
        for (int i = 0; i < 8; ++i) { const int q = tid + 512 * i, row = q >> 4, pc = q & 15;
            *(LAS u32x4*)(Kimg + row * 272 + pc * 16) = kr[i]; *(LAS u32x4*)(Vimg + row * 288 + pc * 16) = vr[i]; }
        bf16x8 qf[4];
#pragma unroll
        for (int kk = 0; kk < 4; ++kk) qf[kk] = qn[kk];
        { const int un = unit + gridDim.x; if (un < 3072) DIL_LOAD(un); }
        asm volatile("s_waitcnt lgkmcnt(0)" ::: "memory"); __builtin_amdgcn_s_barrier(); asm volatile("" ::: "memory");
        const int tb = 2 * (wid >> 1);
        f32x4 s[10];
#pragma unroll
        for (int t = 0; t < 10; ++t) { s[t] = (f32x4){0.f, 0.f, 0.f, 0.f};
#pragma unroll
            for (int kk = 0; kk < 4; ++kk) { const bf16x8 a = *(const LAS bf16x8*)(Kimg + (16 * (tb + t) + fr) * 272 + (32 * kk + 8 * g4) * 2); s[t] = MFMA16(a, qf[kk], s[t]); } }
        const int iq = 16 * wid + fr; float mx = -INFINITY;
#pragma unroll
        for (int t = 0; t < 10; ++t)
#pragma unroll
            for (int e = 0; e < 4; ++e) { const int kkey = 16 * (tb + t) + 4 * g4 + e;
                const bool valid = (kkey >= iq) && (kkey <= iq + 128) && (j > 0 || kkey >= 128);
                s[t][e] = valid ? s[t][e] : -INFINITY; mx = fmaxf(mx, s[t][e]); }
        mx = fmaxf(mx, __shfl_xor(mx, 16)); mx = fmaxf(mx, __shfl_xor(mx, 32));
        float l = 0.f;
#pragma unroll
        for (int t = 0; t < 10; ++t)
#pragma unroll
            for (int e = 0; e < 4; ++e) { s[t][e] = __builtin_amdgcn_exp2f(s[t][e] - mx); l += s[t][e]; }
        l += __shfl_xor(l, 16); l += __shfl_xor(l, 32);
        bf16x8 pf[5];
#pragma unroll
        for (int pp = 0; pp < 5; ++pp) pf[pp] = __builtin_bit_cast(bf16x8, pk8(s[2 * pp], s[2 * pp + 1]));
        f32x4 o[8];
#pragma unroll
        for (int cc = 0; cc < 8; ++cc) { o[cc] = (f32x4){0.f, 0.f, 0.f, 0.f};
#pragma unroll
            for (int pp = 0; pp < 5; ++pp) { LAS unsigned char* a0 = Vimg + (16 * (tb + 2 * pp) + 4 * g4 + (fr >> 2)) * 288 + 32 * cc + 8 * (fr & 3);
                const bf16x8 a = tr2(a0, a0 + 16 * 288); o[cc] = MFMA16(a, pf[pp], o[cc]); } }
        const float inv = 1.0f / l;
        bf16_t* op = proj + tq * NP1 + qcol + 16 * (g4 & 1) + 8 * (g4 >> 1);
#pragma unroll
        for (int pr = 0; pr < 4; ++pr) { u32x2 wa, wb; wa.x = pk2(o[2 * pr][0] * inv, o[2 * pr][1] * inv); wa.y = pk2(o[2 * pr][2] * inv, o[2 * pr][3] * inv);
            wb.x = pk2(o[2 * pr + 1][0] * inv, o[2 * pr + 1][1] * inv); wb.y = pk2(o[2 * pr + 1][2] * inv, o[2 * pr + 1][3] * inv);
            *(u32x4*)(op + 32 * pr) = widen16(wa, wb); }
        if (g4 == 0) lse2[(tq * 3 + g) * 8 + h] = mx + log2f(l);
    }
#undef DIL_DECODE
#undef DIL_LOAD
}
__device__ __forceinline__ void dil_combine(bf16_t* proj, const float* lse2) {
    const int gt = blockIdx.x * 512 + otid(), nt = gridDim.x * 512;
    for (int idx0 = gt; idx0 < T_TOK * 128; idx0 += 4 * nt) {
        u32x4 w0[4], w1[4], w2[4]; float l0[4], l1[4], l2[4];
#pragma unroll
        for (int k = 0; k < 4; ++k) { const int idx = idx0 + k * nt; if (idx < T_TOK * 128) { const size_t t = idx >> 7; const int h = (idx >> 4) & 7, pc = idx & 15;
            l0[k] = lse2[(t * 3 + 0) * 8 + h]; l1[k] = lse2[(t * 3 + 1) * 8 + h]; l2[k] = lse2[(t * 3 + 2) * 8 + h];
            const bf16_t* p0 = proj + t * NP1 + h * 128 + pc * 8; w0[k] = *(const u32x4*)p0; w1[k] = *(const u32x4*)(p0 + 3072); w2[k] = *(const u32x4*)(p0 + 6144); } }
#pragma unroll
        for (int k = 0; k < 4; ++k) { const int idx = idx0 + k * nt; if (idx < T_TOK * 128) { const size_t t = idx >> 7; const int h = (idx >> 4) & 7, pc = idx & 15;
            const float m = fmaxf(l0[k], fmaxf(l1[k], l2[k])); float a0 = __builtin_amdgcn_exp2f(l0[k] - m), a1 = __builtin_amdgcn_exp2f(l1[k] - m), a2 = __builtin_amdgcn_exp2f(l2[k] - m);
            const float inv = 1.0f / (a0 + a1 + a2); a0 *= inv; a1 *= inv; a2 *= inv;
            const u32x4 x0 = w0[k], x1 = w1[k], x2 = w2[k]; u32x4 o;
            o.x = pk2(a0 * bflo(x0.x) + a1 * bflo(x1.x) + a2 * bflo(x2.x), a0 * bfhi(x0.x) + a1 * bfhi(x1.x) + a2 * bfhi(x2.x));
            o.y = pk2(a0 * bflo(x0.y) + a1 * bflo(x1.y) + a2 * bflo(x2.y), a0 * bfhi(x0.y) + a1 * bfhi(x1.y) + a2 * bfhi(x2.y));
            o.z = pk2(a0 * bflo(x0.z) + a1 * bflo(x1.z) + a2 * bflo(x2.z), a0 * bfhi(x0.z) + a1 * bfhi(x1.z) + a2 * bfhi(x2.z));
            o.w = pk2(a0 * bflo(x0.w) + a1 * bflo(x1.w) + a2 * bflo(x2.w), a0 * bfhi(x0.w) + a1 * bfhi(x1.w) + a2 * bfhi(x2.w));
            *(u32x4*)(proj + t * NP1 + h * 128 + pc * 8) = o; } }
    }
}

__device__ __forceinline__ float ret_l2g(int h) { return log2f(1.0f - exp2f(-5.0f - (float)h)); }
__device__ __forceinline__ void ret_kv(LAS unsigned char* lds, const bf16_t* proj, bf16_t* kvb) {
    const int tid = otid(), wid = __builtin_amdgcn_readfirstlane(tid >> 6), lane = tid & 63, fr = lane & 15, g4 = lane >> 4;
    LAS unsigned char* Kimg = lds; LAS unsigned char* Vimg = lds + 38912;
    u32x4 kr[4], vr[8];
#define RKV_LOAD(unit_) do { const int n_ = (unit_) & 63, h_ = ((unit_) >> 6) & 7, b_ = (unit_) >> 9; const size_t t0_ = (size_t)b_ * SEQ + 128 * n_; \
        _Pragma("unroll") for (int i = 0; i < 4; ++i) { const int q = tid + 512 * i, row = q >> 4, pc = q & 15; kr[i] = *(const u32x4*)(proj + (t0_ + row) * NP1 + RK0 + h_ * 128 + pc * 8); } \
        _Pragma("unroll") for (int i = 0; i < 8; ++i) { const int q = tid + 512 * i, row = q >> 5, pc = q & 31; vr[i] = *(const u32x4*)(proj + (t0_ + row) * NP1 + RV0 + h_ * 256 + pc * 8); } } while (0)
    int unit = blockIdx.x;
    if (unit < 1024) RKV_LOAD(unit);
    for (; unit < 1024; unit += gridDim.x) {
        const int h = (unit >> 6) & 7;
        const float l2g = ret_l2g(h);
        __syncthreads();
#pragma unroll
        for (int i = 0; i < 4; ++i) { const int q = tid + 512 * i, row = q >> 4, pc = q & 15;
            const u32x4 w = kr[i];
            const float d = __builtin_amdgcn_exp2f((float)(127 - row) * l2g);
            u32x4 o; o.x = pk2(bflo(w.x) * d, bfhi(w.x) * d); o.y = pk2(bflo(w.y) * d, bfhi(w.y) * d); o.z = pk2(bflo(w.z) * d, bfhi(w.z) * d); o.w = pk2(bflo(w.w) * d, bfhi(w.w) * d);
            *(LAS u32x4*)(Kimg + row * 304 + pc * 16) = o; }
#pragma unroll
        for (int i = 0; i < 8; ++i) { const int q = tid + 512 * i, row = q >> 5, pc = q & 31;
            *(LAS u32x4*)(Vimg + row * 560 + pc * 16) = vr[i]; }
        { const int un = unit + gridDim.x; if (un < 1024) RKV_LOAD(un); }
        asm volatile("s_waitcnt lgkmcnt(0)" ::: "memory"); __builtin_amdgcn_s_barrier(); asm volatile("" ::: "memory");
        f32x4 acc[16];
#pragma unroll
        for (int cc = 0; cc < 16; ++cc) acc[cc] = (f32x4){0.f, 0.f, 0.f, 0.f};
#pragma unroll
        for (int ks = 0; ks < 4; ++ks) {
            LAS unsigned char* ka = Kimg + (32 * ks + 8 * g4 + (fr >> 2)) * 304 + 32 * wid + 8 * (fr & 3);
            const bf16x8 a = tr2(ka, ka + 4 * 304);
#pragma unroll
            for (int cc = 0; cc < 16; ++cc) { LAS unsigned char* va = Vimg + (32 * ks + 8 * g4 + (fr >> 2)) * 560 + 32 * cc + 8 * (fr & 3);
                const bf16x8 bb = tr2(va, va + 4 * 560); acc[cc] = MFMA16(a, bb, acc[cc]); }
        }
        bf16_t* op = kvb + (size_t)unit * 32768 + 16 * wid + 8 * (g4 >> 1) + (size_t)(16 * (g4 & 1) + fr) * 128;
#pragma unroll
        for (int pr = 0; pr < 8; ++pr) { u32x2 wa, wb; wa.x = pk2(acc[2 * pr][0], acc[2 * pr][1]); wa.y = pk2(acc[2 * pr][2], acc[2 * pr][3]);
            wb.x = pk2(acc[2 * pr + 1][0], acc[2 * pr + 1][1]); wb.y = pk2(acc[2 * pr + 1][2], acc[2 * pr + 1][3]);
            *(u32x4*)(op + (size_t)(32 * pr) * 128) = widen16(wa, wb); }
    }
#undef RKV_LOAD
}
__device__ __forceinline__ void ret_scan(bf16_t* kvb) {
    const int gt = blockIdx.x * 512 + otid(), nt = gridDim.x * 512;
    for (int idx = gt; idx < 16 * 8192; idx += nt) { const int bh = idx >> 13, e4 = idx & 8191, h = bh & 7;
        const float cd = exp2f(128.0f * ret_l2g(h));
        bf16_t* base = kvb + (size_t)bh * 64 * 32768 + e4 * 4;
        float s0 = 0.f, s1 = 0.f, s2 = 0.f, s3 = 0.f;
        for (int n0 = 0; n0 < 64; n0 += 8) { u32x2 w[8];
#pragma unroll
            for (int i = 0; i < 8; ++i) w[i] = *(const u32x2*)(base + (size_t)(n0 + i) * 32768);
#pragma unroll
            for (int i = 0; i < 8; ++i) { u32x2 o; o.x = pk2(s0, s1); o.y = pk2(s2, s3); *(u32x2*)(base + (size_t)(n0 + i) * 32768) = o;
                s0 = cd * s0 + bflo(w[i].x); s1 = cd * s1 + bfhi(w[i].x); s2 = cd * s2 + bflo(w[i].y); s3 = cd * s3 + bfhi(w[i].y); } }
    }
}
__device__ __forceinline__ void ret_out(LAS unsigned char* lds, bf16_t* proj, const bf16_t* kvb) {
    const int tid = otid(), wid = __builtin_amdgcn_readfirstlane(tid >> 6), lane = tid & 63, fr = lane & 15, g4 = lane >> 4;
    LAS unsigned char* Kimg = lds; LAS unsigned char* Vimg = lds + 34816;
    for (int unit = blockIdx.x; unit < 1024; unit += gridDim.x) {
        const int n = unit & 63, h = (unit >> 6) & 7, b = unit >> 9;
        const size_t t0 = (size_t)b * SEQ + 128 * n; const float l2g = ret_l2g(h);
        __syncthreads();
        { u32x4 sr[8];
#pragma unroll
        for (int i = 0; i < 8; ++i) { const int q = tid + 512 * i, row = q >> 4, pc = q & 15; sr[i] = *(const u32x4*)(kvb + (size_t)unit * 32768 + row * 128 + pc * 8); }
#pragma unroll
        for (int i = 0; i < 8; ++i) { const int q = tid + 512 * i, row = q >> 4, pc = q & 15; *(LAS u32x4*)(lds + row * 272 + pc * 16) = sr[i]; } }
        const size_t tq = t0 + 16 * wid + fr; const int iq = 16 * wid + fr;
        bf16x8 qf[4];
#pragma unroll
        for (int kk = 0; kk < 4; ++kk) qf[kk] = *(const bf16x8*)(proj + tq * NP1 + RQ0 + h * 128 + 32 * kk + 8 * g4);
        __syncthreads();
        f32x4 acc[16];
        const float qd = __builtin_amdgcn_exp2f((float)(iq + 1) * l2g);
#pragma unroll
        for (int cc = 0; cc < 16; ++cc) { acc[cc] = (f32x4){0.f, 0.f, 0.f, 0.f};
#pragma unroll
            for (int kk = 0; kk < 4; ++kk) { const bf16x8 a = *(const LAS bf16x8*)(lds + (16 * cc + fr) * 272 + (32 * kk + 8 * g4) * 2); acc[cc] = MFMA16(a, qf[kk], acc[cc]); }
            acc[cc] *= qd; }
        __syncthreads();
        { u32x4 kr[4], vr[4];
#pragma unroll
        for (int i = 0; i < 4; ++i) { const int q = tid + 512 * i, row = q >> 4, pc = q & 15; kr[i] = *(const u32x4*)(proj + (t0 + row) * NP1 + RK0 + h * 128 + pc * 8); }
#pragma unroll
        for (int i = 0; i < 4; ++i) { const int q = tid + 512 * i, row = q >> 5, pc = q & 31; vr[i] = *(const u32x4*)(proj + (t0 + row) * NP1 + RV0 + h * 256 + pc * 8); }
#pragma unroll
        for (int i = 0; i < 4; ++i) { const int q = tid + 512 * i, row = q >> 4, pc = q & 15; *(LAS u32x4*)(Kimg + row * 272 + pc * 16) = kr[i]; }
#pragma unroll
        for (int i = 0; i < 4; ++i) { const int q = tid + 512 * i, row = q >> 5, pc = q & 31; *(LAS u32x4*)(Vimg + row * 544 + pc * 16) = vr[i]; }
#pragma unroll
        for (int i = 0; i < 4; ++i) { const int q = tid + 512 * (i + 4), row = q >> 5, pc = q & 31; kr[i] = *(const u32x4*)(proj + (t0 + row) * NP1 + RV0 + h * 256 + pc * 8); }
#pragma unroll
        for (int i = 0; i < 4; ++i) { const int q = tid + 512 * (i + 4), row = q >> 5, pc = q & 31; *(LAS u32x4*)(Vimg + row * 544 + pc * 16) = kr[i]; } }
        __syncthreads();
        const int ntile = (wid | 1) + 1;
        bf16x8 pf[4];
#pragma unroll
        for (int pp = 0; pp < 4; ++pp) {
            if (2 * pp < ntile) {
                f32x4 s0 = (f32x4){0.f, 0.f, 0.f, 0.f}, s1 = (f32x4){0.f, 0.f, 0.f, 0.f};
#pragma unroll
                for (int kk = 0; kk < 4; ++kk) { const bf16x8 a0 = *(const LAS bf16x8*)(Kimg + (32 * pp + fr) * 272 + (32 * kk + 8 * g4) * 2);
                    const bf16x8 a1 = *(const LAS bf16x8*)(Kimg + (32 * pp + 16 + fr) * 272 + (32 * kk + 8 * g4) * 2);
                    s0 = MFMA16(a0, qf[kk], s0); s1 = MFMA16(a1, qf[kk], s1); }
#pragma unroll
                for (int e = 0; e < 4; ++e) { const int j0 = 32 * pp + 4 * g4 + e, j1 = j0 + 16;
                    s0[e] = (iq >= j0) ? s0[e] * __builtin_amdgcn_exp2f((float)(iq - j0) * l2g) : 0.f;
                    s1[e] = (iq >= j1) ? s1[e] * __builtin_amdgcn_exp2f((float)(iq - j1) * l2g) : 0.f; }
                pf[pp] = __builtin_bit_cast(bf16x8, pk8(s0, s1));
            } else pf[pp] = (bf16x8){0, 0, 0, 0, 0, 0, 0, 0};
        }
#pragma unroll
        for (int pp = 0; pp < 4; ++pp) {
            if (2 * pp < ntile) {
#pragma unroll
                for (int cc = 0; cc < 16; ++cc) { LAS unsigned char* a0 = Vimg + (32 * pp + 4 * g4 + (fr >> 2)) * 544 + 32 * cc + 8 * (fr & 3);
                    const bf16x8 a = tr2(a0, a0 + 16 * 544); acc[cc] = MFMA16(a, pf[pp], acc[cc]); }
            }
        }
        bf16_t* gp = proj + tq * NP1 + RG0 + h * 256 + 4 * g4;
        u32x2 gwv[16];
#pragma unroll
        for (int cc = 0; cc < 16; ++cc) gwv[cc] = *(const u32x2*)(gp + 16 * cc);
        float sm = 0.f;
#pragma unroll
        for (int cc = 0; cc < 16; ++cc) sm += (acc[cc][0] + acc[cc][1]) + (acc[cc][2] + acc[cc][3]);
        sm += __shfl_xor(sm, 16); sm += __shfl_xor(sm, 32);
        const float mean = sm * (1.0f / 256.0f); float vq = 0.f;
#pragma unroll
        for (int cc = 0; cc < 16; ++cc) { const f32x4 d = acc[cc] - mean; vq += (d[0] * d[0] + d[1] * d[1]) + (d[2] * d[2] + d[3] * d[3]); }
        vq += __shfl_xor(vq, 16); vq += __shfl_xor(vq, 32);
        const float rstd = rsqrtf(vq * (1.0f / 256.0f) + 1e-5f);
#pragma unroll
        for (int cc = 0; cc < 16; ++cc) { const u32x2 gw = gwv[cc];
            u32x2 w; w.x = pk2((acc[cc][0] - mean) * rstd * bflo(gw.x), (acc[cc][1] - mean) * rstd * bfhi(gw.x));
            w.y = pk2((acc[cc][2] - mean) * rstd * bflo(gw.y), (acc[cc][3] - mean) * rstd * bfhi(gw.y));
            *(u32x2*)(gp + 16 * cc) = w; }
    }
}

__device__ __forceinline__ GD gd_plain(const bf16_t* A, int lda, const bf16_t* Bt, int ldb, int M, int N, int K) {
    GD d; d.type = 3; d.A = A; d.Bt = Bt; d.lda = lda; d.ldb = ldb; d.M = M; d.N = N; d.K = K; d.nb = 1; d.nh = 1;
    d.sAb = d.sAh = d.sBb = d.sBh = d.sOb = d.sOh = 0; d.O = nullptr; d.ldc = 0; d.base = nullptr; d.scale = 1.f; d.act = 0; d.split = 1 << 30; d.base0 = 0; d.base1 = 0;
    d.gate = nullptr; d.add = 0; d.cs = nullptr; d.ss = nullptr; d.hb = nullptr; d.ssout = nullptr; d.crot = 0; d.zrow = 0; d.wgm = 4; return d;
}
constexpr int NSTEPS = 41;
#ifndef WGM_SWIGLU
#define WGM_SWIGLU 8
#endif
#ifndef WGM_PROJ
#define WGM_PROJ 4
#endif
#ifndef WGM_GATES
#define WGM_GATES 4
#endif
#define SYNC_CASES case 2: case 3: case 6: case 8: case 13: case 15: case 18: case 24: case 25: case 29: case 31: case 32: case 33: case 38: case 39:
__device__ __forceinline__ bool sync_after(int st) {
    switch (st) { SYNC_CASES return true; default: return false; }
}

__global__ void __launch_bounds__(512) mega(Params p) {
    extern __shared__ __attribute__((aligned(16))) unsigned char lds_raw[];
    LAS unsigned char* lds = (LAS unsigned char*)lds_raw;
    cg::grid_group grid = cg::this_grid();
    unsigned char* ws = p.ws;
    const float* x = p.in[0]; const float* mem = p.in[1]; const int* pos = (const int*)p.in[2];
    float* hbuf = p.out;
    bf16_t* hb = (bf16_t*)(ws + R1);
    bf16_t* proj = (bf16_t*)(ws + R0);
    bf16_t* hid = (bf16_t*)(ws + R0);
    bf16_t* W1IN = (bf16_t*)(ws + R2); bf16_t* W1OUT = (bf16_t*)(ws + R0 + 256 * MIB);
    bf16_t* WMIX1 = (bf16_t*)(ws + R2); float* CS = (float*)(ws + R2 + 64 * MIB);
    bf16_t* KVB = (bf16_t*)(ws + R2); bf16_t* WG = (bf16_t*)(ws + R2 + 64 * MIB); bf16_t* WA = (bf16_t*)(ws + R2 + 80 * MIB); bf16_t* WR = (bf16_t*)(ws + R2 + 84 * MIB);
    float* LSE = (float*)(ws + R2 + 92 * MIB);
    bf16_t* WOUT = (bf16_t*)(ws + R2); bf16_t* WQC = (bf16_t*)(ws + R2 + 8 * MIB); bf16_t* M2T = (bf16_t*)(ws + R2 + 40 * MIB); bf16_t* VWT = (bf16_t*)(ws + R2 + 48 * MIB); bf16_t* WKV = (bf16_t*)(ws + R2 + 16 * MIB); bf16_t* WO = (bf16_t*)(ws + R2 + 32 * MIB);
    bf16_t* QX = (bf16_t*)(ws + R0); float* SC = (float*)(ws + R0 + 64 * MIB); bf16_t* PB = (bf16_t*)(ws + R0 + 128 * MIB); bf16_t* OX = (bf16_t*)(ws + R0 + 160 * MIB);
    bf16_t* MEMN = (bf16_t*)(ws + MEMN_OFF); bf16_t* KX = (bf16_t*)(ws + KX_OFF); bf16_t* VX = (bf16_t*)(ws + VT_OFF);
    bf16_t* W2IN = (bf16_t*)(ws + R0 + 256 * MIB); bf16_t* W2OUT = (bf16_t*)(ws + R0 + 256 * MIB + 46137344);
    unsigned* BAR = (unsigned*)(ws + CTL0);
    float* SS1 = (float*)(ws + CTL0 + CTL_BAR_BYTES); float* SS2 = SS1 + T_TOK; float* SS3 = SS2 + T_TOK; float* SS0 = (float*)(ws + SS0_OFF);
    volatile LAS unsigned* xst = (volatile LAS unsigned*)(lds + 143360);
    if (threadIdx.x < 4) xst[threadIdx.x] = 0u;
    __syncthreads();
    XcdBarrier xbar = xcd_barrier_post(BAR, xst);
    if (p.lo < 0) grid.sync();

    for (int st = p.lo; st < p.hi; ++st) {
        bool isg = false; GD d = gd_plain(nullptr, 0, nullptr, 0, 0, 0, 0);
        switch (st) {
        case 0: conv_job(lds, p.in[4], 2 * DFF, DM, W1IN, 2 * DFF, 1, 0, p.in[3]); break;
        case 1: conv_job(lds, p.in[5], DM, DFF, W1OUT, DM, 0, 0); break;
        case 2: norm_rows(x, nullptr, hb, T_TOK, SS0); break;
        case 3: d = gd_plain(hb, DM, W1IN, DM, T_TOK, 2 * DFF, DM); d.type = 0; d.O = hid; d.ldc = DFF; d.ss = SS0; d.wgm = WGM_SWIGLU; isg = true; break;
        case 4: d = gd_plain(hid, DFF, W1OUT, DFF, T_TOK, DM, DFF); d.type = 1; d.O = hbuf; d.ldc = DM; d.base = x; d.scale = 0.5f; d.hb = hb; d.ssout = SS1; isg = true; break;
        case 5: conv_job(lds, p.in[7], 19456, DM, WMIX1, NP1, 2, 0, p.in[6]); break;
        case 6: cs_table(pos, CS); break;
        case 8: d = gd_plain(hb, DM, WMIX1, DM, T_TOK, NP1, DM); d.type = 2; d.O = proj; d.ldc = NP1; d.cs = CS; d.ss = SS1; d.wgm = WGM_PROJ; isg = true; break;
        case 9: dil_attn(lds, proj, LSE); break;
        case 10: ret_kv(lds, proj, KVB); break;
        case 11: conv_job(lds, p.in[7], 19456, DM, WG, 4096, 0, NP1, p.in[6]); break;
        case 12: conv_job(lds, p.in[8], DM, 1024, WA, DM, 0, 0); break;
        case 13: conv_job(lds, p.in[9], DM, DM, WR, DM, 0, 0); break;
        case 14: ret_scan(KVB); break;
        case 15: dil_combine(proj, LSE); break;
        case 17: ret_out(lds, proj, KVB); break;
        case 18: d = gd_plain(hb, DM, WG, DM, T_TOK, 4096, DM); d.O = proj; d.ldc = NP1; d.act = 1; d.split = 8; d.base0 = GA0; d.base1 = GB0; d.ss = SS1; d.wgm = WGM_GATES; isg = true; break;
        case 19: d = gd_plain(proj, NP1, WA, 1024, T_TOK, DM, 1024); d.type = 4; d.O = proj + MG0; d.ldc = NP1; d.gate = proj + GA0; d.add = 0; isg = true; break;
        case 20: d = gd_plain(proj + RG0, NP1, WR, DM, T_TOK, DM, DM); d.type = 4; d.O = proj + MG0; d.ldc = NP1; d.gate = proj + GB0; d.add = 1; isg = true; break;
        case 21: conv_job(lds, p.in[10], DM, DM, WOUT, DM, 0, 0); break;
        case 22: cast_job(p.in[13], p.in[11], WQC, DM, DM); break;
        case 23: conv_job(lds, p.in[14], 2 * DM, DM, WKV, 2 * DM, 0, 0); break;
        case 24: conv_job(lds, p.in[15], DM, DM, WO, DM, 0, 0); norm_rows(mem, p.in[12], MEMN, 512); break;
        case 25: d = gd_plain(proj + MG0, NP1, WOUT, DM, T_TOK, DM, DM); d.type = 1; d.O = hbuf; d.ldc = DM; d.base = hbuf; d.scale = 1.f; d.hb = hb; d.ssout = SS2; isg = true; break;
        case 26: d = gd_plain(MEMN, DM, WKV, DM, 512, DM, DM); d.O = KX; d.ldc = DM; isg = true; break;
        case 27: d = gd_plain(MEMN, DM, WKV + (size_t)DM * DM, DM, 512, DM, DM); d.O = VX; d.ldc = DM; d.crot = 16; isg = true; break;
        case 28: conv_job(lds, p.in[17], 2 * DFF, DM, W2IN, 2 * DFF, 1, 0, p.in[16], 32, (int)gridDim.x - 32); break;
        case 29: conv_job(lds, p.in[18], DM, DFF, W2OUT, DM, 0, 0, nullptr, 32, (int)gridDim.x - 32); break;
        case 30: d = gd_plain(KX, DM, WQC, DM, 256, DM, 512); d.nb = 2; d.nh = 4; d.sAb = 256L * DM; d.sAh = 512; d.sBb = 0; d.sBh = 512;
                 d.O = M2T; d.ldc = DM; d.sOb = 4L * 256 * DM; d.sOh = 256L * DM; d.scale = 0.04419417382415922f * LOG2E; isg = true; break;
        case 31: d = gd_plain(WO, DM, VX, DM, DM, 256, 512); d.nb = 2; d.nh = 4; d.sAb = 0; d.sAh = 512; d.sBb = 256L * DM; d.sBh = 512;
                 d.O = VWT; d.ldc = 1024; d.sOb = (long)DM * 1024; d.sOh = 256; d.crot = 64; isg = true; break;
        case 32: d = gd_plain(hb, DM, M2T, DM, SEQ, 256, DM); d.type = 5; d.nb = 2; d.nh = 4; d.sAb = (long)SEQ * DM; d.sAh = 0; d.sBb = 4L * 256 * DM; d.sBh = 256L * DM;
                 d.O = PB; d.ldc = 1024; d.sOb = (long)SEQ * 1024; d.sOh = 256; d.ss = SS2; d.zrow = SEQ; isg = true; break;
        case 33: d = gd_plain(PB, 1024, VWT, 1024, SEQ, DM, 1024); d.type = 1; d.nb = 2; d.nh = 1; d.sAb = (long)SEQ * 1024; d.sBb = (long)DM * 1024;
                 d.O = hbuf; d.ldc = DM; d.sOb = (long)SEQ * DM; d.base = hbuf; d.scale = 1.f; d.hb = hb; d.ssout = SS3; d.zrow = SEQ; isg = true; break;
        case 38: d = gd_plain(hb, DM, W2IN, DM, T_TOK, 2 * DFF, DM); d.type = 0; d.O = hid; d.ldc = DFF; d.ss = SS3; d.wgm = WGM_SWIGLU; isg = true; break;
        case 39: d = gd_plain(hid, DFF, W2OUT, DFF, T_TOK, DM, DFF); d.type = 1; d.O = hbuf; d.ldc = DM; d.base = hbuf; d.scale = 0.5f; isg = true; break;
        case 40: final_norm(hbuf, p.in[19], T_TOK); break;
        default: break;
        }
        if (isg) {
            __syncthreads();
            pg8::Gemm g{d.A, d.Bt, d.K, d.lda, d.ldb};
            pg8::Sched S; S.nM = d.M / 256; S.nN = d.N / 256; S.per = S.nM * S.nN; S.total = S.per * d.nb * d.nh; S.G = gridDim.x; S.c = (int)((blockIdx.x + gridDim.x - d.crot) % gridDim.x); S.nh = d.nh; S.WGM = d.wgm;
            S.tA = 256L * d.lda * 2; S.tB = 256L * d.ldb * 2; S.sAb = d.sAb * 2; S.sAh = d.sAh * 2; S.sBb = d.sBb * 2; S.sBh = d.sBh * 2;
            switch (d.type) {
            case 0: { EpiSwiglu E{(bf16_t*)d.O, d.ldc, d.ss}; pg8::gemm_phase(lds, g, S, E); } break;
            case 1: { EpiF32 E{(float*)d.O, d.ldc, d.base, d.scale, d.sOb, d.sOh, d.hb, d.ssout, d.zrow}; pg8::gemm_phase(lds, g, S, E); } break;
            case 2: { EpiProj E{(bf16_t*)d.O, d.ldc, d.cs, d.ss}; pg8::gemm_phase(lds, g, S, E); } break;
            case 3: { EpiAct E{(bf16_t*)d.O, d.ldc, d.scale, d.act, d.split, d.base0, d.base1, d.sOb, d.sOh, d.ss}; pg8::gemm_phase(lds, g, S, E); } break;
            case 5: { EpiSoftmax E{(bf16_t*)d.O, d.ldc, d.sOb, d.sOh, (LAS float*)(lds + 131072), d.ss, d.zrow}; pg8::gemm_phase(lds, g, S, E); } break;
            default: { EpiGate E{(bf16_t*)d.O, d.ldc, d.gate, d.add}; pg8::gemm_phase(lds, g, S, E); } break;
            }
            __syncthreads();
        }
        if (st + 1 < p.hi && sync_after(st)) xcd_barrier(xbar);
    }
}

extern "C" void kernel_launch(void* const* d_in, const int* in_sizes, int n_in, void* d_out, int out_size, void* d_ws, size_t ws_size, hipStream_t stream) {
    static int grid_blocks = 0;
    if (!grid_blocks) {
        if (n_in != 20 || ws_size < (size_t)WS_NEED) { fprintf(stderr, "kernel_launch: unexpected inputs (n_in %d, ws %zu need %ld)\n", n_in, ws_size, (long)WS_NEED); grid_blocks = -1; return; }
        int dev = 0, cus = 0, per_cu = 0;
        (void)hipGetDevice(&dev);
        (void)hipDeviceGetAttribute(&cus, hipDeviceAttributeMultiprocessorCount, dev);
        if (hipFuncSetAttribute((const void*)mega, hipFuncAttributeMaxDynamicSharedMemorySize, LDS_BYTES) != hipSuccess) { fprintf(stderr, "hipFuncSetAttribute failed\n"); grid_blocks = -1; return; }
        (void)hipOccupancyMaxActiveBlocksPerMultiprocessor(&per_cu, (const void*)mega, 512, LDS_BYTES);
        if (per_cu < 1) { fprintf(stderr, "occupancy query gave %d\n", per_cu); per_cu = 1; }
        grid_blocks = cus * 1;
    }
    if (grid_blocks < 0) return;
    (void)hipMemsetAsync((char*)d_ws + CTL0, 0, CTL_BYTES, stream);
    Params p{};
    for (int i = 0; i < 20; ++i) p.in[i] = (const float*)d_in[i];
    p.out = (float*)d_out; p.ws = (unsigned char*)d_ws;
#if ONE_LAUNCH
    p.lo = 0; p.hi = NSTEPS;
    void* args[] = {&p};
    hipError_t e = hipLaunchCooperativeKernel((const void*)mega, dim3(grid_blocks), dim3(512), args, LDS_BYTES, stream);
    if (e != hipSuccess) fprintf(stderr, "cooperative launch failed: %s (grid %d)\n", hipGetErrorString(e), grid_blocks);
#else
    int lo = 0;
    for (int st = 0; st < NSTEPS; ++st) {
        bool cut = (st == NSTEPS - 1);
        switch (st) { SYNC_CASES cut = true; break; default: break; }
        if (cut) { p.lo = lo; p.hi = st + 1; hipLaunchKernelGGL(mega, dim3(grid_blocks), dim3(512), LDS_BYTES, stream, p); lo = st + 1; }
    }
#endif
}
```

```cpp
#include <hip/hip_runtime.h>
#include <hip/hip_cooperative_groups.h>
#include <cstdio>
namespace cg = cooperative_groups;

#ifndef ONE_LAUNCH
#define ONE_LAUNCH 1
#endif

#define LAS __attribute__((address_space(3)))
typedef unsigned short bf16_t;
typedef short bf16x8 __attribute__((ext_vector_type(8)));
typedef short s16x4 __attribute__((ext_vector_type(4)));
typedef float f32x4 __attribute__((ext_vector_type(4)));
typedef float f32x2 __attribute__((ext_vector_type(2)));
typedef unsigned u32x4 __attribute__((ext_vector_type(4)));
typedef unsigned u32x2 __attribute__((ext_vector_type(2)));
typedef __bf16 bf16x2_t __attribute__((ext_vector_type(2)));

constexpr int T_TOK = 16384, DM = 2048, SEQ = 8192, DFF = 5632, NP1 = 15360;
constexpr long MIB = 1048576;
constexpr long R0 = 0, R1 = 503316480, R2 = R1 + 67108864, WS_END = R2 + 100663296;
constexpr int RQ0 = 9216, RK0 = 10240, RV0 = 11264, RG0 = 13312;
constexpr int GA0 = 1024, GB0 = 4096, MG0 = 7168;
constexpr float LOG2E = 1.4426950408889634f;
constexpr int LDS_BYTES = 143376;
constexpr long CTL0 = WS_END;
constexpr long CTL_BAR_BYTES = 16384;
constexpr long CTL_BYTES = CTL_BAR_BYTES + 3 * 65536;
constexpr long SS0_OFF = CTL0 + CTL_BYTES;
constexpr long MEMN_OFF = CTL0 + 1 * MIB, KX_OFF = MEMN_OFF + 2 * MIB, VT_OFF = KX_OFF + 2 * MIB, WS_NEED = VT_OFF + 2 * MIB;

struct Params {
    const float* in[20];
    float* out; unsigned char* ws;
    int lo, hi;
};

__device__ __forceinline__ unsigned pk2(float a, float b) { f32x2 v = {a, b}; return __builtin_bit_cast(unsigned, __builtin_convertvector(v, bf16x2_t)); }
__device__ __forceinline__ float bflo(unsigned w) { return __uint_as_float(w << 16); }
__device__ __forceinline__ float bfhi(unsigned w) { return __uint_as_float(w & 0xffff0000u); }
__device__ __forceinline__ float silu_f(float x) { return x * __builtin_amdgcn_rcpf(1.f + __builtin_amdgcn_exp2f(-LOG2E * x)); }
__device__ __forceinline__ float sigm_f(float x) { return __builtin_amdgcn_rcpf(1.f + __builtin_amdgcn_exp2f(-LOG2E * x)); }
__device__ __forceinline__ u32x4 pk8(const f32x4 a, const f32x4 b) { u32x4 w; w.x = pk2(a[0], a[1]); w.y = pk2(a[2], a[3]); w.z = pk2(b[0], b[1]); w.w = pk2(b[2], b[3]); return w; }
__device__ __forceinline__ float wave_sum(float v) { for (int o = 32; o >= 1; o >>= 1) v += __shfl_xor(v, o); return v; }
__device__ __forceinline__ float wave_max(float v) { for (int o = 32; o >= 1; o >>= 1) v = fmaxf(v, __shfl_xor(v, o)); return v; }
__device__ __forceinline__ bf16x8 tr2(LAS unsigned char* p0, LAS unsigned char* p1) {
    s16x4 a = __builtin_amdgcn_ds_read_tr16_b64_v4i16((LAS s16x4*)p0);
    s16x4 b = __builtin_amdgcn_ds_read_tr16_b64_v4i16((LAS s16x4*)p1);
    return __builtin_shufflevector(a, b, 0, 1, 2, 3, 4, 5, 6, 7);
}
__device__ __forceinline__ int otid() { int t = threadIdx.x; asm volatile("" : "+v"(t)); return t; }
#define XB_TMO      128
#define XB_XCNT(j)  (256  + 64 * (j))
#define XB_XSUB(j)  (1280 + 64 * (j))
#define XB_XGEN(j)  (2304 + 64 * (j))
#define XB_TOP      3328
#define XB_TOPGEN   3392
#define XB_SPIN_CAP (1u << 20)
__device__ __forceinline__ unsigned xb_ld(unsigned* p)              { return __hip_atomic_load(p, __ATOMIC_RELAXED, __HIP_MEMORY_SCOPE_AGENT); }
__device__ __forceinline__ unsigned xb_add(unsigned* p, unsigned v) { return __hip_atomic_fetch_add(p, v, __ATOMIC_RELAXED, __HIP_MEMORY_SCOPE_AGENT); }
__device__ __forceinline__ unsigned xb_xcc_id() { return (unsigned)__builtin_amdgcn_s_getreg((3 << 11) | 20) & 0xFu; }
#define XB_SPIN(cond, bar) do { unsigned _sp = 0; while (cond) { __builtin_amdgcn_s_sleep(1); \
    if ((++_sp & 255u) == 0u) { if (xb_ld(&(bar)[XB_TMO])) break; if (_sp > XB_SPIN_CAP) { atomicAdd(&(bar)[XB_TMO], 1u); break; } } } } while (0)
struct XcdBarrier { unsigned* bar; unsigned x; volatile LAS unsigned* st; };
__device__ __forceinline__ XcdBarrier xcd_barrier_post(unsigned* bar, volatile LAS unsigned* st) {
    XcdBarrier b; b.bar = bar; b.x = xb_xcc_id(); b.st = st;
    if (threadIdx.x == 0) (void)xb_add(&bar[XB_XCNT(b.x)], 1u);
    return b;
}
__device__ __forceinline__ void xcd_barrier_complete(unsigned* bar, unsigned x, unsigned& nloc, unsigned& nx) {
    const unsigned G = gridDim.x * gridDim.y * gridDim.z;
    unsigned sum, cnt, mine, sp = 0u;
    for (;;) {
        sum = 0u; cnt = 0u; mine = 0u;
        unsigned cv[16];
        { unsigned* cbase = &bar[XB_XCNT(0)];
          asm volatile("global_load_dword %0, %16, off sc1\n\t"
            "global_load_dword %1, %16, off offset:256 sc1\n\t"
            "global_load_dword %2, %16, off offset:512 sc1\n\t"
            "global_load_dword %3, %16, off offset:768 sc1\n\t"
            "global_load_dword %4, %16, off offset:1024 sc1\n\t"
            "global_load_dword %5, %16, off offset:1280 sc1\n\t"
            "global_load_dword %6, %16, off offset:1536 sc1\n\t"
            "global_load_dword %7, %16, off offset:1792 sc1\n\t"
            "global_load_dword %8, %16, off offset:2048 sc1\n\t"
            "global_load_dword %9, %16, off offset:2304 sc1\n\t"
            "global_load_dword %10, %16, off offset:2560 sc1\n\t"
            "global_load_dword %11, %16, off offset:2816 sc1\n\t"
            "global_load_dword %12, %16, off offset:3072 sc1\n\t"
            "global_load_dword %13, %16, off offset:3328 sc1\n\t"
            "global_load_dword %14, %16, off offset:3584 sc1\n\t"
            "global_load_dword %15, %16, off offset:3840 sc1\n\t"
            "s_waitcnt vmcnt(0)"
            : "=&v"(cv[0]), "=&v"(cv[1]), "=&v"(cv[2]), "=&v"(cv[3]), "=&v"(cv[4]), "=&v"(cv[5]), "=&v"(cv[6]), "=&v"(cv[7]), "=&v"(cv[8]), "=&v"(cv[9]), "=&v"(cv[10]), "=&v"(cv[11]), "=&v"(cv[12]), "=&v"(cv[13]), "=&v"(cv[14]), "=&v"(cv[15]) : "v"(cbase) : "memory"); }
#pragma unroll
        for (unsigned j = 0; j < 16; ++j) { const unsigned c = cv[j]; sum += c; cnt += (c > 0u) ? 1u : 0u; mine = (j == x) ? c : mine; }
        if (sum == G) break;
        __builtin_amdgcn_s_sleep(1);
        if ((++sp & 255u) == 0u) { if (xb_ld(&bar[XB_TMO])) break; if (sp > XB_SPIN_CAP) { atomicAdd(&bar[XB_TMO], 1u); break; } }
    }
    nloc = mine > 0u ? mine : 1u; nx = cnt > 0u ? cnt : 1u;
}
__device__ __forceinline__ void xcd_barrier(const XcdBarrier& b) {
    asm volatile("s_waitcnt vmcnt(0)" ::: "memory");
    __syncthreads();
    if (threadIdx.x == 0) {
        unsigned* bar = b.bar;
        __builtin_amdgcn_s_waitcnt(0);
        unsigned nloc = b.st[0], nx = b.st[1];
        if (nloc == 0u) { xcd_barrier_complete(bar, b.x, nloc, nx); b.st[0] = nloc; b.st[1] = nx; }
        const unsigned old = xb_add(&bar[XB_XSUB(b.x)], 1u);
        const unsigned gen = old / nloc;
        if (old + 1u == (gen + 1u) * nloc) {
            __builtin_amdgcn_fence(__ATOMIC_RELEASE, "agent");
            asm volatile("s_waitcnt vmcnt(0)" ::: "memory");
            const unsigned og = xb_add(&bar[XB_TOP], 1u);
            const unsigned tg = og / nx;
            if (og + 1u == (tg + 1u) * nx) xb_add(&bar[XB_TOPGEN], 1u);
            else XB_SPIN(xb_ld(&bar[XB_TOPGEN]) == tg, bar);
            __builtin_amdgcn_fence(__ATOMIC_ACQUIRE, "agent");
            xb_add(&bar[XB_XGEN(b.x)], 1u);
            asm volatile("s_waitcnt vmcnt(0)" ::: "memory");
        } else {
            XB_SPIN(xb_ld(&bar[XB_XGEN(b.x)]) == gen, bar);
            __builtin_amdgcn_fence(__ATOMIC_ACQUIRE, "agent");
            asm volatile("s_waitcnt vmcnt(0)" ::: "memory");
        }
    }
    __syncthreads();
}
__device__ __forceinline__ u32x4 widen16(u32x2 a, u32x2 b) {
    const auto r0 = __builtin_amdgcn_permlane16_swap(a.x, b.x, false, false);
    const auto r1 = __builtin_amdgcn_permlane16_swap(a.y, b.y, false, false);
    return (u32x4){r0[0], r1[0], r0[1], r1[1]};
}
#define MFMA16(a, b, c) __builtin_amdgcn_mfma_f32_16x16x32_bf16((a), (b), (c), 0, 0, 0)

struct Pre { float v[2]; };
__device__ __forceinline__ Pre pre_rows(const float* ss, int rowbase) { Pre p; p.v[0] = 1.0f; p.v[1] = 1.0f;
    if (ss) { const float* q = ss + rowbase;
        asm volatile("global_load_dword %0, %2, off\n\tglobal_load_dword %1, %2, off offset:512" : "=&v"(p.v[0]), "=&v"(p.v[1]) : "v"(q) : "memory"); }
    return p; }
__device__ __forceinline__ float pre_get(const Pre& p, int ai, int m, int fr) { return __shfl(p.v[ai], m * 16 + fr); }
__device__ __forceinline__ float rstd_pre(const float* ss, float v) { return ss ? rsqrtf(v * (1.0f / 2048.0f) + 1e-6f) : 1.0f; }
namespace pg8 {
constexpr int BM = 256, BK = 64, HALF = 128, HTB = HALF * BK * 2, NXCD = 8;
__device__ __forceinline__ int lds_byte(int r, int c) { const int st = (r >> 4) * 2 + (c >> 5), rr = r & 15, cc = c & 31, ob = rr * 64 + cc * 2; return st * 1024 + (ob ^ (((ob >> 9) & 1) << 5)); }
__device__ __forceinline__ void stage_rc(int b, int& R, int& C) { const int st = b / 1024, sb = b % 1024, swz = sb ^ (((sb >> 9) & 1) << 5); R = (st >> 1) * 16 + swz / 64; C = (st & 1) * 32 + (swz % 64) / 2; }
__device__ __forceinline__ int perm32(int rho) { const int n = rho >> 4, i = rho & 15; return 8 * (i >> 2) + 4 * n + (i & 3); }

struct Unit { int pm, pn, zb, zh; long ao, bo; };
struct Gemm { const bf16_t* A; const bf16_t* Bt; int K, lda, ldb; };
struct Sched {
    int nM, nN, per, total, G, c, nh, WGM; unsigned mnig; long tA, tB, sAb, sAh, sBb, sBh;
    __device__ __forceinline__ bool next(int i, Unit& u) const {
        const long L = (long)i * G + c; if (L >= total) return false;
        int z = 0, wgid = (int)L;
        if (total != per) { z = (int)(L / per); wgid = (int)(L - (long)z * per); }
        { const int q = per / NXCD, r = per % NXCD, xcd = wgid % NXCD, off = wgid / NXCD; wgid = (xcd < r ? xcd * (q + 1) : r * (q + 1) + (xcd - r) * q) + off; }
        const int nig = WGM * nN, gid = (int)(((unsigned long long)(unsigned)wgid * mnig) >> 32), rem = wgid - gid * nig,     fm = gid * WGM, gsz = (nM - fm) < WGM ? (nM - fm) : WGM;
        if (gsz == WGM) { u.pm = fm + (rem & (WGM - 1)); u.pn = rem >> __builtin_ctz((unsigned)WGM); } else { u.pm = fm + (rem % gsz); u.pn = rem / gsz; }
        if (z == 0) { u.zb = 0; u.zh = 0; } else { u.zb = z / nh; u.zh = z - u.zb * nh; }
        u.ao = u.zb * sAb + u.zh * sAh + u.pm * tA; u.bo = u.zb * sBb + u.zh * sBh + u.pn * tB; return true;
    }
};

template <class Epi>
__device__ __forceinline__ void gemm_phase(LAS unsigned char* lds, const Gemm g, const Sched& S, const Epi& E) {
    const int tid = otid(), wid = __builtin_amdgcn_readfirstlane(tid >> 6), lane = tid & 63, wr = wid >> 2, wc = wid & 3, fr = lane & 15, fq = lane >> 4;
    const int nt = g.K / BK;
    unsigned voffA[2], voffB[2];
#pragma unroll
    for (int i = 0; i < 2; ++i) { int R, C; stage_rc(tid * 16 + i * 8192, R, C); const int Rb = Epi::PERM ? ((R & ~31) + perm32(R & 31)) : R;
        voffA[i] = (unsigned)(R * g.lda + C) * 2u; voffB[i] = (unsigned)(Rb * g.ldb + C) * 2u; }
    const size_t kstep = (size_t)(BK * 2);
    const size_t hstepA = (size_t)HALF * g.lda * 2, hstepB = (size_t)HALF * g.ldb * 2;
    const unsigned ldsw = (unsigned)wid * 1024u;
    const int aoff = lds_byte(wr * 64 + fr, fq * 8), boff = lds_byte(wc * 32 + fr, fq * 8);
#define PG8_SA(b, h) (((b) * 2 + (h)) * HTB)
#define PG8_SB(b, h) ((4 + (b) * 2 + (h)) * HTB)
#define PG8_STAGE(bufoff, gbase, voff) do { _Pragma("unroll") for (int _i = 0; _i < 2; ++_i) \
        __builtin_amdgcn_global_load_lds((const unsigned*)((const char*)(gbase) + (voff)[_i]), (LAS unsigned*)(lds + (bufoff) + ldsw + _i * 8192), 16, 0, 0); } while (0)
#define PG8_LDA(dst, b, h) do { _Pragma("unroll") for (int m = 0; m < 4; ++m) _Pragma("unroll") for (int k = 0; k < 2; ++k) dst[m][k] = *(const LAS bf16x8*)(lds + PG8_SA(b, h) + aoff + m * 2048 + k * 1024); } while (0)
#define PG8_LDB(dst, b, h) do { _Pragma("unroll") for (int n = 0; n < 2; ++n) _Pragma("unroll") for (int k = 0; k < 2; ++k) dst[n][k] = *(const LAS bf16x8*)(lds + PG8_SB(b, h) + boff + n * 2048 + k * 1024); } while (0)
#define PG8_MMA(ai, bj, At, Bt) do { __builtin_amdgcn_s_setprio(1); _Pragma("unroll") for (int m = 0; m < 4; ++m) _Pragma("unroll") for (int n = 0; n < 2; ++n) _Pragma("unroll") for (int k = 0; k < 2; ++k) \
        acc[ai][bj][m][n] = __builtin_amdgcn_mfma_f32_16x16x32_bf16(Bt[n][k], At[m][k], acc[ai][bj][m][n], 0, 0, 0); __builtin_amdgcn_s_setprio(0); } while (0)
#define PG8_WAIT_V(n) asm volatile("s_waitcnt vmcnt(" #n ")" ::: "memory")
#define PG8_WAIT_L(n) asm volatile("s_waitcnt lgkmcnt(" #n ")" ::: "memory")
#define PG8_BAR __builtin_amdgcn_s_barrier()
#define PG8_SCHED __builtin_amdgcn_sched_barrier(0)
    Unit cur, nxt; int ui = 0;
    if (!S.next(0, cur)) return;
    f32x4 acc[2][2][4][2];
#pragma unroll
    for (int a = 0; a < 2; ++a)
#pragma unroll
        for (int b = 0; b < 2; ++b)
#pragma unroll
            for (int m = 0; m < 4; ++m)
#pragma unroll
                for (int n = 0; n < 2; ++n) acc[a][b][m][n] = (f32x4){0.f, 0.f, 0.f, 0.f};
    bf16x8 At[4][2], B0[2][2], B1[2][2];
    const char* cA = (const char*)g.A + cur.ao; const char* cB = (const char*)g.Bt + cur.bo;
    PG8_STAGE(PG8_SB(0, 0), cB, voffB); PG8_STAGE(PG8_SA(0, 0), cA, voffA); PG8_STAGE(PG8_SB(0, 1), cB + hstepB, voffB); PG8_STAGE(PG8_SA(0, 1), cA + hstepA, voffA);
    if (wr == 1) PG8_BAR;
    PG8_WAIT_V(4); PG8_BAR;
    PG8_STAGE(PG8_SB(1, 0), cB + kstep, voffB); PG8_STAGE(PG8_SA(1, 0), cA + kstep, voffA); PG8_STAGE(PG8_SB(1, 1), cB + hstepB + kstep, voffB);
    PG8_WAIT_V(6); PG8_BAR;
    for (;;) {
        const Pre pre = E.prefetch(cur, wr, fr);
        const bool has_next = S.next(ui + 1, nxt);
        const char* nA = has_next ? (const char*)g.A + nxt.ao : cA; const char* nB = has_next ? (const char*)g.Bt + nxt.bo : cB;
        for (int t = 0; t < nt; t += 2) {
            const bool last = (t == nt - 2);
            const char* a1 = cA + (size_t)(t + 1) * kstep;
            const char* a2 = last ? nA : cA + (size_t)(t + 2) * kstep; const char* b2 = last ? nB : cB + (size_t)(t + 2) * kstep;
            const char* a3 = a2 + kstep; const char* b3 = b2 + kstep;
            PG8_LDB(B0, 0, 0); PG8_SCHED; PG8_LDA(At, 0, 0); PG8_STAGE(PG8_SA(1, 1), a1 + hstepA, voffA);
            PG8_WAIT_L(8); PG8_BAR; PG8_WAIT_L(0); PG8_MMA(0, 0, At, B0); PG8_BAR; PG8_SCHED;
            PG8_LDB(B1, 0, 1); PG8_STAGE(PG8_SB(0, 0), b2, voffB);
            PG8_BAR; PG8_WAIT_L(0); PG8_MMA(0, 1, At, B1); PG8_BAR;
            PG8_LDA(At, 0, 1); PG8_STAGE(PG8_SA(0, 0), a2, voffA);
            PG8_BAR; PG8_WAIT_L(0); PG8_MMA(1, 0, At, B0); PG8_BAR; PG8_SCHED;
            PG8_STAGE(PG8_SB(0, 1), b2 + hstepB, voffB);
            PG8_WAIT_V(6); PG8_BAR; PG8_MMA(1, 1, At, B1); PG8_BAR;
            PG8_LDB(B0, 1, 0); PG8_SCHED; PG8_LDA(At, 1, 0); PG8_STAGE(PG8_SA(0, 1), a2 + hstepA, voffA);
            PG8_WAIT_L(8); PG8_BAR; PG8_WAIT_L(0); PG8_MMA(0, 0, At, B0); PG8_BAR; PG8_SCHED;
            PG8_LDB(B1, 1, 1); PG8_STAGE(PG8_SB(1, 0), b3, voffB);
            PG8_BAR; PG8_WAIT_L(0); PG8_MMA(0, 1, At, B1); PG8_BAR;
            PG8_LDA(At, 1, 1); PG8_STAGE(PG8_SA(1, 0), a3, voffA);
            PG8_BAR; PG8_WAIT_L(0); PG8_MMA(1, 0, At, B0); PG8_BAR; PG8_SCHED;
            PG8_STAGE(PG8_SB(1, 1), b3 + hstepB, voffB);
            PG8_WAIT_V(6); PG8_BAR; PG8_MMA(1, 1, At, B1); PG8_BAR;
        }
        E(acc, cur, wr, wc, fr, fq, pre);
        if (!has_next) break;
#pragma unroll
        for (int a = 0; a < 2; ++a)
#pragma unroll
            for (int b = 0; b < 2; ++b)
#pragma unroll
                for (int m = 0; m < 4; ++m)
#pragma unroll
                    for (int n = 0; n < 2; ++n) acc[a][b][m][n] = (f32x4){0.f, 0.f, 0.f, 0.f};
        cur = nxt; cA = nA; cB = nB; ++ui;
    }
    PG8_WAIT_V(0);
    if (wr == 0) PG8_BAR;
    PG8_BAR;
#undef PG8_SA
#undef PG8_SB
#undef PG8_STAGE
#undef PG8_LDA
#undef PG8_LDB
#undef PG8_MMA
#undef PG8_WAIT_V
#undef PG8_WAIT_L
#undef PG8_BAR
#undef PG8_SCHED
}
}
using pg8::Unit;
typedef f32x4 Acc[2][2][4][2];

struct GD {
    int type;
    const bf16_t* A; const bf16_t* Bt; int lda, ldb, M, N, K;
    int nb, nh; long sAb, sAh, sBb, sBh, sOb, sOh;
    void* O; int ldc; const float* base; float scale; int act; int split, base0, base1;
    const bf16_t* gate; int add; const float* cs;
    const float* ss; bf16_t* hb; float* ssout; int crot; int zrow; int wgm;
};

__device__ __forceinline__ float rstd_of(const float* ss, int row) { return ss ? rsqrtf(ss[row] * (1.0f / DM) + 1e-6f) : 1.0f; }
struct EpiSwiglu { static constexpr bool PERM = true; bf16_t* O; int ldc; const float* ss;
    __device__ __forceinline__ Pre prefetch(const Unit& u, int wr, int fr) const { return pre_rows(ss, u.pm * 256 + wr * 64 + (int)(threadIdx.x & 63)); }
    __device__ __forceinline__ void operator()(const Acc& acc, const Unit& u, int wr, int wc, int fr, int fq, const Pre& pre) const {
        const int row0 = u.pm * 256 + wr * 64 + fr, col0 = u.pn * 128 + wc * 32 + 8 * fq;
        float rsq[2][4];
#pragma unroll
        for (int ai = 0; ai < 2; ++ai)
#pragma unroll
            for (int m = 0; m < 4; ++m) rsq[ai][m] = rstd_pre(ss, pre_get(pre, ai, m, fr));
#pragma unroll
        for (int ai = 0; ai < 2; ++ai)
#pragma unroll
            for (int m = 0; m < 4; ++m) {
                f32x4 v0, v1; const float rs = rsq[ai][m];
#pragma unroll
                for (int e = 0; e < 4; ++e) { v0[e] = silu_f(acc[ai][0][m][0][e] * rs) * (acc[ai][1][m][0][e] * rs); v1[e] = silu_f(acc[ai][0][m][1][e] * rs) * (acc[ai][1][m][1][e] * rs); }
                *(u32x4*)(O + (size_t)(row0 + ai * 128 + m * 16) * ldc + col0) = pk8(v0, v1);
            }
    }
};
struct EpiF32 { static constexpr bool PERM = true; float* O; int ldc; const float* base; float scale; long sOb, sOh; bf16_t* hb; float* ssout; int zrow;
    __device__ __forceinline__ Pre prefetch(const Unit&, int, int) const { Pre p; p.v[0] = 1.0f; p.v[1] = 1.0f; return p; }
    __device__ __forceinline__ void operator()(const Acc& acc, const Unit& u, int wr, int wc, int fr, int fq, const Pre& pre) const {
        const int row0 = u.pm * 256 + wr * 64 + fr, col0 = u.pn * 256 + wc * 32 + 8 * fq;
        const size_t zo = (size_t)(u.zb * sOb + u.zh * sOh);
#pragma unroll
        for (int ai = 0; ai < 2; ++ai) {
            f32x4 bv[4][2][2];
            if (base) {
#pragma unroll
                for (int m = 0; m < 4; ++m) { const size_t off = zo + (size_t)(row0 + ai * 128 + m * 16) * ldc + col0;
#pragma unroll
                    for (int bj = 0; bj < 2; ++bj)
#pragma unroll
                        for (int n = 0; n < 2; ++n) bv[m][bj][n] = *(const f32x4*)(base + off + bj * 128 + n * 4); }
            }
#pragma unroll
            for (int m = 0; m < 4; ++m) { const size_t off = zo + (size_t)(row0 + ai * 128 + m * 16) * ldc + col0; float sq = 0.f;
#pragma unroll
                for (int bj = 0; bj < 2; ++bj) { f32x4 v0 = acc[ai][bj][m][0] * scale, v1 = acc[ai][bj][m][1] * scale;
                    if (base) { v0 += bv[m][bj][0]; v1 += bv[m][bj][1]; }
                    *(f32x4*)(O + off + bj * 128) = v0; *(f32x4*)(O + off + bj * 128 + 4) = v1;
                    if (hb) { *(u32x4*)(hb + off + bj * 128) = pk8(v0, v1);
                        sq += (v0[0] * v0[0] + v0[1] * v0[1]) + (v0[2] * v0[2] + v0[3] * v0[3]) + (v1[0] * v1[0] + v1[1] * v1[1]) + (v1[2] * v1[2] + v1[3] * v1[3]); } }
                if (ssout) { sq += __shfl_xor(sq, 16); sq += __shfl_xor(sq, 32); if (fq == 0) __hip_atomic_fetch_add(ssout + u.zb * zrow + row0 + ai * 128 + m * 16, sq, __ATOMIC_RELAXED, __HIP_MEMORY_SCOPE_AGENT); } }
            asm volatile("" ::: "memory");
        }
    }
};
struct EpiProj { static constexpr bool PERM = true; bf16_t* O; int ldc; const float* cs; const float* ss;
    __device__ __forceinline__ Pre prefetch(const Unit& u, int wr, int fr) const { return pre_rows(ss, u.pm * 256 + wr * 64 + (int)(threadIdx.x & 63)); }
    __device__ __forceinline__ void operator()(const Acc& acc, const Unit& u, int wr, int wc, int fr, int fq, const Pre& pre) const {
        const int tile = u.pn; int mode = 0; float scale0 = 1.f;
        if (tile < 36) { const int tg = tile % 12; if (tg < 4) { mode = 1; scale0 = 0.08838834764831845f * LOG2E; } else if (tg < 8) mode = 1; }
        else if (tile < 40) mode = 1;
        else if (tile < 44) { mode = 1; scale0 = 0.08838834764831845f; }
        else if (tile >= 52) mode = 2;
        const int row0 = u.pm * 256 + wr * 64 + fr;
        float rsq[2][4];
#pragma unroll
        for (int ai = 0; ai < 2; ++ai)
#pragma unroll
            for (int m = 0; m < 4; ++m) rsq[ai][m] = rstd_pre(ss, pre_get(pre, ai, m, fr));
        if (mode == 1) {
            const int head2 = wc >> 1, i0 = 32 * (wc & 1) + 8 * fq;
#pragma unroll
            for (int ai = 0; ai < 2; ++ai) {
                f32x4 cv[4][4]; float rsv[4];
#pragma unroll
                for (int m = 0; m < 4; ++m) { const int row = row0 + ai * 128 + m * 16; rsv[m] = rsq[ai][m];
                    const f32x4* cp = (const f32x4*)(cs + (size_t)row * 128 + i0 * 2); cv[m][0] = cp[0]; cv[m][1] = cp[1]; cv[m][2] = cp[2]; cv[m][3] = cp[3]; }
#pragma unroll
                for (int m = 0; m < 4; ++m) { const int row = row0 + ai * 128 + m * 16; const float scale = scale0 * rsv[m];
                    const f32x4 c0 = cv[m][0], c1 = cv[m][1], c2 = cv[m][2], c3 = cv[m][3];
                    const f32x4 xa = acc[ai][0][m][0], xb = acc[ai][0][m][1], ya = acc[ai][1][m][0], yb = acc[ai][1][m][1];
                    f32x4 o1a, o1b, o2a, o2b;
                    o1a[0] = (xa[0] * c0[0] - ya[0] * c0[1]) * scale; o2a[0] = (ya[0] * c0[0] + xa[0] * c0[1]) * scale;
                    o1a[1] = (xa[1] * c0[2] - ya[1] * c0[3]) * scale; o2a[1] = (ya[1] * c0[2] + xa[1] * c0[3]) * scale;
                    o1a[2] = (xa[2] * c1[0] - ya[2] * c1[1]) * scale; o2a[2] = (ya[2] * c1[0] + xa[2] * c1[1]) * scale;
                    o1a[3] = (xa[3] * c1[2] - ya[3] * c1[3]) * scale; o2a[3] = (ya[3] * c1[2] + xa[3] * c1[3]) * scale;
                    o1b[0] = (xb[0] * c2[0] - yb[0] * c2[1]) * scale; o2b[0] = (yb[0] * c2[0] + xb[0] * c2[1]) * scale;
                    o1b[1] = (xb[1] * c2[2] - yb[1] * c2[3]) * scale; o2b[1] = (yb[1] * c2[2] + xb[1] * c2[3]) * scale;
                    o1b[2] = (xb[2] * c3[0] - yb[2] * c3[1]) * scale; o2b[2] = (yb[2] * c3[0] + xb[2] * c3[1]) * scale;
                    o1b[3] = (xb[3] * c3[2] - yb[3] * c3[3]) * scale; o2b[3] = (yb[3] * c3[2] + xb[3] * c3[3]) * scale;
                    bf16_t* rp = O + (size_t)row * ldc + tile * 256 + head2 * 128 + i0;
                    *(u32x4*)rp = pk8(o1a, o1b); *(u32x4*)(rp + 64) = pk8(o2a, o2b); }
                asm volatile("" ::: "memory"); }
        } else {
            const int col0 = tile * 256 + wc * 32 + 8 * fq;
#pragma unroll
            for (int ai = 0; ai < 2; ++ai)
#pragma unroll
                for (int m = 0; m < 4; ++m) { const float rs = rsq[ai][m];
#pragma unroll
                    for (int bj = 0; bj < 2; ++bj) { f32x4 v0 = acc[ai][bj][m][0] * rs, v1 = acc[ai][bj][m][1] * rs;
                        if (mode == 2) {
#pragma unroll
                            for (int e = 0; e < 4; ++e) { v0[e] = silu_f(v0[e]); v1[e] = silu_f(v1[e]); } }
                        *(u32x4*)(O + (size_t)(row0 + ai * 128 + m * 16) * ldc + col0 + bj * 128) = pk8(v0, v1); } }
        }
    }
};
struct EpiAct { static constexpr bool PERM = true; bf16_t* O; int ldc; float scale; int act; int split, base0, base1; long sOb, sOh; const float* ss;
    __device__ __forceinline__ Pre prefetch(const Unit& u, int wr, int fr) const { return pre_rows(ss, u.pm * 256 + wr * 64 + (int)(threadIdx.x & 63)); }
    __device__ __forceinline__ void operator()(const Acc& acc, const Unit& u, int wr, int wc, int fr, int fq, const Pre& pre) const {
        const int colt = (u.pn < split) ? base0 + u.pn * 256 : base1 + (u.pn - split) * 256;
        const int row0 = u.pm * 256 + wr * 64 + fr, col0 = colt + wc * 32 + 8 * fq;
        bf16_t* Oz = O + (size_t)(u.zb * sOb + u.zh * sOh);
        float rsq[2][4];
#pragma unroll
        for (int ai = 0; ai < 2; ++ai)
#pragma unroll
            for (int m = 0; m < 4; ++m) rsq[ai][m] = rstd_pre(ss, pre_get(pre, ai, m, fr));
#pragma unroll
        for (int ai = 0; ai < 2; ++ai)
#pragma unroll
            for (int m = 0; m < 4; ++m) { const float rs = scale * rsq[ai][m];
#pragma unroll
                for (int bj = 0; bj < 2; ++bj) { f32x4 v0 = acc[ai][bj][m][0] * rs, v1 = acc[ai][bj][m][1] * rs;
                    if (act == 1) {
#pragma unroll
                        for (int e = 0; e < 4; ++e) { v0[e] = sigm_f(v0[e]); v1[e] = sigm_f(v1[e]); } }
                    *(u32x4*)(Oz + (size_t)(row0 + ai * 128 + m * 16) * ldc + col0 + bj * 128) = pk8(v0, v1); } }
    }
};
struct EpiSoftmax { static constexpr bool PERM = true; bf16_t* O; int ldc; long sOb, sOh; LAS float* X; const float* ss; int zrow;
    __device__ __forceinline__ Pre prefetch(const Unit& u, int wr, int fr) const { return pre_rows(ss, u.zb * zrow + u.pm * 256 + wr * 64 + (int)(threadIdx.x & 63)); }
    __device__ __forceinline__ void operator()(const Acc& acc, const Unit& u, int wr, int wc, int fr, int fq, const Pre& pre) const {
        const int row0 = u.pm * 256 + wr * 64 + fr, col0 = wc * 32 + 8 * fq;
        bf16_t* Oz = O + (size_t)(u.zb * sOb + u.zh * sOh);
        float rs[2][4];
#pragma unroll
        for (int ai = 0; ai < 2; ++ai)
#pragma unroll
            for (int m = 0; m < 4; ++m) rs[ai][m] = rstd_pre(ss, pre_get(pre, ai, m, fr));
#pragma unroll
        for (int ai = 0; ai < 2; ++ai)
#pragma unroll
            for (int m = 0; m < 4; ++m) { float mx = -INFINITY;
#pragma unroll
                for (int bj = 0; bj < 2; ++bj)
#pragma unroll
                    for (int n = 0; n < 2; ++n) { const f32x4 a = acc[ai][bj][m][n]; mx = fmaxf(mx, fmaxf(fmaxf(a[0], a[1]), fmaxf(a[2], a[3]))); }
                mx *= rs[ai][m];
                mx = fmaxf(mx, __shfl_xor(mx, 16)); mx = fmaxf(mx, __shfl_xor(mx, 32));
                if (fq == 0) X[(ai * 128 + wr * 64 + m * 16 + fr) * 4 + wc] = mx; }
        asm volatile("s_waitcnt lgkmcnt(0)" ::: "memory"); __builtin_amdgcn_s_barrier(); asm volatile("" ::: "memory");
        float rmx[2][4];
#pragma unroll
        for (int ai = 0; ai < 2; ++ai)
#pragma unroll
            for (int m = 0; m < 4; ++m) { const f32x4 q = *(const LAS f32x4*)(X + (ai * 128 + wr * 64 + m * 16 + fr) * 4);
                const float mx = fmaxf(fmaxf(q[0], q[1]), fmaxf(q[2], q[3])); rmx[ai][m] = mx; float sm = 0.f; const float r = rs[ai][m];
#pragma unroll
                for (int bj = 0; bj < 2; ++bj)
#pragma unroll
                    for (int n = 0; n < 2; ++n)
#pragma unroll
                        for (int e = 0; e < 4; ++e) sm += __builtin_amdgcn_exp2f(acc[ai][bj][m][n][e] * r - mx);
                sm += __shfl_xor(sm, 16); sm += __shfl_xor(sm, 32);
                if (fq == 0) X[1024 + (ai * 128 + wr * 64 + m * 16 + fr) * 4 + wc] = sm; }
        asm volatile("s_waitcnt lgkmcnt(0)" ::: "memory"); __builtin_amdgcn_s_barrier(); asm volatile("" ::: "memory");
#pragma unroll
        for (int ai = 0; ai < 2; ++ai)
#pragma unroll
            for (int m = 0; m < 4; ++m) { const f32x4 q = *(const LAS f32x4*)(X + 1024 + (ai * 128 + wr * 64 + m * 16 + fr) * 4);
                const float inv = 1.0f / ((q[0] + q[1]) + (q[2] + q[3])); const float mx = rmx[ai][m], r = rs[ai][m];
#pragma unroll
                for (int bj = 0; bj < 2; ++bj) { f32x4 v0, v1;
#pragma unroll
                    for (int e = 0; e < 4; ++e) { v0[e] = __builtin_amdgcn_exp2f(acc[ai][bj][m][0][e] * r - mx) * inv; v1[e] = __builtin_amdgcn_exp2f(acc[ai][bj][m][1][e] * r - mx) * inv; }
                    *(u32x4*)(Oz + (size_t)(row0 + ai * 128 + m * 16) * ldc + col0 + bj * 128) = pk8(v0, v1); } }
    }
};
struct EpiGate { static constexpr bool PERM = true; bf16_t* O; int ldc; const bf16_t* gate; int add;
    __device__ __forceinline__ Pre prefetch(const Unit&, int, int) const { Pre p; p.v[0] = 1.0f; p.v[1] = 1.0f; return p; }
    __device__ __forceinline__ void operator()(const Acc& acc, const Unit& u, int wr, int wc, int fr, int fq, const Pre& pre) const {
        const int row0 = u.pm * 256 + wr * 64 + fr, col0 = u.pn * 256 + wc * 32 + 8 * fq;
#pragma unroll
        for (int ai = 0; ai < 2; ++ai) {
            u32x4 gw[4][2], pw[4][2];
#pragma unroll
            for (int m = 0; m < 4; ++m)
#pragma unroll
                for (int bj = 0; bj < 2; ++bj) { const size_t off = (size_t)(row0 + ai * 128 + m * 16) * ldc + col0 + bj * 128;
                    gw[m][bj] = *(const u32x4*)(gate + off); if (add) pw[m][bj] = *(const u32x4*)(O + off); }
#pragma unroll
            for (int m = 0; m < 4; ++m)
#pragma unroll
                for (int bj = 0; bj < 2; ++bj) { const size_t off = (size_t)(row0 + ai * 128 + m * 16) * ldc + col0 + bj * 128;
                    const u32x4 g = gw[m][bj];
                    f32x4 v0 = acc[ai][bj][m][0], v1 = acc[ai][bj][m][1];
                    v0[0] *= bflo(g.x); v0[1] *= bfhi(g.x); v0[2] *= bflo(g.y); v0[3] *= bfhi(g.y);
                    v1[0] *= bflo(g.z); v1[1] *= bfhi(g.z); v1[2] *= bflo(g.w); v1[3] *= bfhi(g.w);
                    if (add) { const u32x4 q = pw[m][bj];
                        v0[0] += bflo(q.x); v0[1] += bfhi(q.x); v0[2] += bflo(q.y); v0[3] += bfhi(q.y);
                        v1[0] += bflo(q.z); v1[1] += bfhi(q.z); v1[2] += bflo(q.w); v1[3] += bfhi(q.w); }
                    *(u32x4*)(O + off) = pk8(v0, v1); }
            asm volatile("" ::: "memory");
        }
    }
};

__device__ __forceinline__ int srccol64(int mode, int p0, int n0) {
    if (mode == 0) return p0 + n0;
    const int tile = n0 >> 8, rem = n0 & 255, bj = rem >> 7, j = rem & 127;
    if (mode == 1) return bj * DFF + tile * 128 + j;
    bool rope;
    if (tile < 36) rope = (tile % 12) < 8; else rope = tile < 44;
    if (!rope) return n0;
    return tile * 256 + (j >> 6) * 128 + bj * 64 + (j & 63);
}
__device__ __forceinline__ void conv_job(LAS unsigned char* lds, const float* src, int ld, int K, bf16_t* dst, int nrows, int mode, int p0, const float* gain = nullptr, int rank0 = 0, int nranks = 0) {
    const int tid = otid(), c4 = tid & 31, kr = tid >> 5;
    const int nNt = nrows >> 7, nKt = K >> 7, nu = nNt * nKt;
    if (nranks == 0) nranks = gridDim.x;
    int u = (int)blockIdx.x - rank0; if (u < 0 || u >= nu) return;
    f32x4 va[8], vb[8], gq[2];
#define CONV_LOAD(dstv, uu) do { const int n_ = ((uu) % nNt) * 128, k_ = ((uu) / nNt) * 128; \
        const float* sp_ = src + (size_t)(k_ + kr * 8) * ld + srccol64(mode, p0, n_ + (c4 >> 4) * 64) + (c4 & 15) * 4; \
        _Pragma("unroll") for (int it = 0; it < 8; ++it) dstv[it] = __builtin_nontemporal_load((const f32x4*)(sp_ + (size_t)it * ld)); } while (0)
#define CONV_GAIN(uu) do { if (gain) { const int kg_ = ((uu) / nNt) * 128 + kr * 8; gq[0] = *(const f32x4*)(gain + kg_); gq[1] = *(const f32x4*)(gain + kg_ + 4); } } while (0)
#define CONV_EMIT(v, uu, ugain, unext) do { const int n0 = ((uu) % nNt) * 128, k0 = ((uu) / nNt) * 128; \
        if (gain) { _Pragma("unroll") for (int it = 0; it < 4; ++it) { v[it] *= gq[0][it]; v[it + 4] *= gq[1][it]; } } \
        asm volatile("s_waitcnt lgkmcnt(0)" ::: "memory"); __builtin_amdgcn_s_barrier(); asm volatile("" ::: "memory");     \
        _Pragma("unroll") for (int e = 0; e < 4; ++e) { \
            u32x4 w; w.x = pk2(v[0][e], v[1][e]); w.y = pk2(v[2][e], v[3][e]); w.z = pk2(v[4][e], v[5][e]); w.w = pk2(v[6][e], v[7][e]); \
            *(LAS u32x4*)(lds + (c4 + 32 * e) * 272 + kr * 16) = w; } \
        if ((ugain) < nu) CONV_GAIN(ugain); \
        if ((unext) < nu) CONV_LOAD(v, unext); \
        asm volatile("s_waitcnt lgkmcnt(0)" ::: "memory"); __builtin_amdgcn_s_barrier(); asm volatile("" ::: "memory"); \
        _Pragma("unroll") for (int i = 0; i < 4; ++i) { const int p = tid + 512 * i, n = p >> 4, pc = p & 15; \
            const u32x4 w = *(const LAS u32x4*)(lds + ((n >> 2) + 32 * (n & 3)) * 272 + pc * 16); \
            *(u32x4*)(dst + (size_t)(n0 + n) * K + k0 + pc * 8) = w; } } while (0)
    CONV_LOAD(va, u);
    CONV_GAIN(u);
    if (u + nranks < nu) CONV_LOAD(vb, u + nranks);
    for (; u < nu; u += 2 * nranks) {
        CONV_EMIT(va, u, u + nranks, u + 2 * nranks);
        if (u + nranks < nu) CONV_EMIT(vb, u + nranks, u + 2 * nranks, u + 3 * nranks);
    }
#undef CONV_LOAD
#undef CONV_EMIT
#undef CONV_GAIN
}
__device__ __forceinline__ void cast_job(const float* src, const float* gain, bf16_t* dst, int rows, int cols) {
    const int gt = blockIdx.x * 512 + otid(), nt = gridDim.x * 512, per = cols >> 3;
    for (int idx = gt; idx < rows * per; idx += nt) { const int k = idx / per, c = (idx % per) * 8; const float g = gain[k];
        const f32x4 a = __builtin_nontemporal_load((const f32x4*)(src + (size_t)k * cols + c)), b = __builtin_nontemporal_load((const f32x4*)(src + (size_t)k * cols + c + 4));
        *(u32x4*)(dst + (size_t)k * cols + c) = pk8(a * g, b * g); }
}
__device__ __forceinline__ void norm_rows(const float* src, const float* gain, bf16_t* dst, int nrows, float* ssq = nullptr) {
    const int tid = otid(), lane = tid & 63, gw = blockIdx.x * 8 + (tid >> 6), nw = gridDim.x * 8;
    for (int row = gw; row < nrows; row += nw) {
        const f32x4* p = (const f32x4*)(src + (size_t)row * DM); f32x4 v[8]; float ss = 0.f;
#pragma unroll
        for (int i = 0; i < 8; ++i) { v[i] = __builtin_nontemporal_load(p + i * 64 + lane); ss += v[i][0] * v[i][0] + v[i][1] * v[i][1] + v[i][2] * v[i][2] + v[i][3] * v[i][3]; }
        ss = wave_sum(ss); const float r = gain ? rsqrtf(ss * (1.0f / DM) + 1e-6f) : 1.0f;
        if (!gain && lane == 0) ssq[row] = ss;
#pragma unroll
        for (int i = 0; i < 8; ++i) { const f32x4 gn = gain ? ((const f32x4*)gain)[i * 64 + lane] : (f32x4){1.f, 1.f, 1.f, 1.f}; u32x2 w; w.x = pk2(v[i][0] * r * gn[0], v[i][1] * r * gn[1]); w.y = pk2(v[i][2] * r * gn[2], v[i][3] * r * gn[3]);
            *(u32x2*)(dst + (size_t)row * DM + (i * 64 + lane) * 4) = w; }
    }
}
__device__ __forceinline__ void final_norm(float* h, const float* gain, int nrows) {
    const int tid = otid(), lane = tid & 63, gw = blockIdx.x * 8 + (tid >> 6), nw = gridDim.x * 8;
    f32x4 gn[8];
#pragma unroll
    for (int i = 0; i < 8; ++i) gn[i] = ((const f32x4*)gain)[i * 64 + lane];
    for (int row = gw; row < nrows; row += nw) {
        f32x4* p = (f32x4*)(h + (size_t)row * DM); f32x4 v[8]; float ss = 0.f;
#pragma unroll
        for (int i = 0; i < 8; ++i) { v[i] = p[i * 64 + lane]; ss += v[i][0] * v[i][0] + v[i][1] * v[i][1] + v[i][2] * v[i][2] + v[i][3] * v[i][3]; }
        ss = wave_sum(ss); const float r = rsqrtf(ss * (1.0f / DM) + 1e-6f);
#pragma unroll
        for (int i = 0; i < 8; ++i) __builtin_nontemporal_store(v[i] * r * gn[i], p + i * 64 + lane);
    }
}
__device__ __forceinline__ void cs_table(const int* pos, float* cs) {
    const int gt = blockIdx.x * 512 + otid(), nt = gridDim.x * 512;
    const bool inv_const = (nt & 63) == 0;
    float inv = powf(10000.0f, -(float)(gt & 63) * (1.0f / 64.0f));
    for (int e = gt; e < T_TOK * 64; e += nt) { const int t = e >> 6, i = e & 63;
        if (!inv_const) inv = powf(10000.0f, -(float)i * (1.0f / 64.0f));
        const float ang = (float)pos[t] * inv;
        double rev = (double)ang * 0.15915494309189535; rev -= rint(rev); const float fr = (float)rev;
        f32x2 o; o.x = __builtin_amdgcn_cosf(fr); o.y = __builtin_amdgcn_sinf(fr); *(f32x2*)(cs + (size_t)e * 2) = o; }
}
__device__ __forceinline__ void softmax_rows(const float* sc, bf16_t* P, int nrows) {
    const int tid = otid(), lane = tid & 63, gw = blockIdx.x * 8 + (tid >> 6), nw = gridDim.x * 8;
    for (int row = gw; row < nrows; row += nw) {
        const f32x4 v = *(const f32x4*)(sc + (size_t)row * 256 + lane * 4);
        const float mx = wave_max(fmaxf(fmaxf(v[0], v[1]), fmaxf(v[2], v[3])));
        f32x4 p; p[0] = __builtin_amdgcn_exp2f(v[0] - mx); p[1] = __builtin_amdgcn_exp2f(v[1] - mx); p[2] = __builtin_amdgcn_exp2f(v[2] - mx); p[3] = __builtin_amdgcn_exp2f(v[3] - mx);
        const float inv = 1.0f / wave_sum(p[0] + p[1] + p[2] + p[3]);
        u32x2 w; w.x = pk2(p[0] * inv, p[1] * inv); w.y = pk2(p[2] * inv, p[3] * inv);
        *(u32x2*)(P + (size_t)row * 256 + lane * 4) = w;
    }
}

__device__ __forceinline__ void dil_attn(LAS unsigned char* lds, bf16_t* proj, float* lse2) {
    const int tid = otid(), wid = __builtin_amdgcn_readfirstlane(tid >> 6), lane = tid & 63, fr = lane & 15, g4 = lane >> 4;
    LAS unsigned char* Kimg = lds; LAS unsigned char* Vimg = lds + 69632;
    u32x4 kr[8], vr[8]; bf16x8 qn[4];
#define DIL_DECODE(unit_) const int jc = (unit_) & 63; int rest = (unit_) >> 6; const int h = rest & 7; rest >>= 3; const int g = rest % 3, b = rest / 3; \
        const int r = 1 << (2 * g), nb = 64 >> (2 * g), c = jc / nb, j = jc % nb; const int qcol = g * 3072 + h * 128; const size_t tb0 = (size_t)b * SEQ + c;
#define DIL_LOAD(unit_) do { DIL_DECODE(unit_) \
        _Pragma("unroll") for (int i = 0; i < 8; ++i) { const int q = tid + 512 * i, row = q >> 4, pc = q & 15; \
            const int pk = (j == 0 && row < 128) ? row : 128 * (j - 1) + row; \
            const bf16_t* rp = proj + (tb0 + (size_t)pk * r) * NP1 + qcol + pc * 8; \
            kr[i] = *(const u32x4*)(rp + 1024); vr[i] = *(const u32x4*)(rp + 2048); } \
        const size_t tq_ = tb0 + (size_t)(128 * j + 16 * wid + fr) * r; \
        _Pragma("unroll") for (int kk = 0; kk < 4; ++kk) qn[kk] = *(const bf16x8*)(proj + tq_ * NP1 + qcol + 32 * kk + 8 * g4); } while (0)
    int unit = blockIdx.x;
    if (unit < 3072) DIL_LOAD(unit);
    for (; unit < 3072; unit += gridDim.x) {
        DIL_DECODE(unit)
        const size_t tq = tb0 + (size_t)(128 * j + 16 * wid + fr) * r;
        __syncthreads();
#pragma unroll
        for (int i = 0; i < 8; ++i) { const int q = tid + 512 * i, row = q >> 4, pc = q & 15;
            *(LAS u32x4*)(Kimg + row * 272 + pc * 16) = kr[i]; *(LAS u32x4*)(Vimg + row * 288 + pc * 16) = vr[i]; }
        bf16x8 qf[4];
#pragma unroll
        for (int kk = 0; kk < 4; ++kk) qf[kk] = qn[kk];
        { const int un = unit + gridDim.x; if (un < 3072) DIL_LOAD(un); }
        asm volatile("s_waitcnt lgkmcnt(0)" ::: "memory"); __builtin_amdgcn_s_barrier(); asm volatile("" ::: "memory");
        const int tb = 2 * (wid >> 1);
        f32x4 s[10];
#pragma unroll
        for (int t = 0; t < 10; ++t) { s[t] = (f32x4){0.f, 0.f, 0.f, 0.f};
#pragma unroll
            for (int kk = 0; kk < 4; ++kk) { const bf16x8 a = *(const LAS bf16x8*)(Kimg + (16 * (tb + t) + fr) * 272 + (32 * kk + 8 * g4) * 2); s[t] = MFMA16(a, qf[kk], s[t]); } }
        const int iq = 16 * wid + fr; float mx = -INFINITY;
#pragma unroll
        for (int t = 0; t < 10; ++t)
#pragma unroll
            for (int e = 0; e < 4; ++e) { const int kkey = 16 * (tb + t) + 4 * g4 + e;
                const bool valid = (kkey >= iq) && (kkey <= iq + 128) && (j > 0 || kkey >= 128);
                s[t][e] = valid ? s[t][e] : -INFINITY; mx = fmaxf(mx, s[t][e]); }
        mx = fmaxf(mx, __shfl_xor(mx, 16)); mx = fmaxf(mx, __shfl_xor(mx, 32));
        float l = 0.f;
#pragma unroll
        for (int t = 0; t < 10; ++t)
#pragma unroll
            for (int e = 0; e < 4; ++e) { s[t][e] = __builtin_amdgcn_exp2f(s[t][e] - mx); l += s[t][e]; }
        l += __shfl_xor(l, 16); l += __shfl_xor(l, 32);
        bf16x8 pf[5];
#pragma unroll
        for (int pp = 0; pp < 5; ++pp) pf[pp] = __builtin_bit_cast(bf16x8, pk8(s[2 * pp], s[2 * pp + 1]));
        f32x4 o[8];
#pragma unroll
        for (int cc = 0; cc < 8; ++cc) { o[cc] = (f32x4){0.f, 0.f, 0.f, 0.f};
#pragma unroll
            for (int pp = 0; pp < 5; ++pp) { LAS unsigned char* a0 = Vimg + (16 * (tb + 2 * pp) + 4 * g4 + (fr >> 2)) * 288 + 32 * cc + 8 * (fr & 3);
                const bf16x8 a = tr2(a0, a0 + 16 * 288); o[cc] = MFMA16(a, pf[pp], o[cc]); } }
        const float inv = 1.0f / l;
        bf16_t* op = proj + tq * NP1 + qcol + 16 * (g4 & 1) + 8 * (g4 >> 1);
#pragma unroll
        for (int pr = 0; pr < 4; ++pr) { u32x2 wa, wb; wa.x = pk2(o[2 * pr][0] * inv, o[2 * pr][1] * inv); wa.y = pk2(o[2 * pr][2] * inv, o[2 * pr][3] * inv);
            wb.x = pk2(o[2 * pr + 1][0] * inv, o[2 * pr + 1][1] * inv); wb.y = pk2(o[2 * pr + 1][2] * inv, o[2 * pr + 1][3] * inv);
            *(u32x4*)(op + 32 * pr) = widen16(wa, wb); }
        if (g4 == 0) lse2[(tq * 3 + g) * 8 + h] = mx + log2f(l);
    }
#undef DIL_DECODE
#undef DIL_LOAD
}
__device__ __forceinline__ void dil_combine(bf16_t* proj, const float* lse2) {
    const int gt = blockIdx.x * 512 + otid(), nt = gridDim.x * 512;
    for (int idx0 = gt; idx0 < T_TOK * 128; idx0 += 4 * nt) {
        u32x4 w0[4], w1[4], w2[4]; float l0[4], l1[4], l2[4];
#pragma unroll
        for (int k = 0; k < 4; ++k) { const int idx = idx0 + k * nt; if (idx < T_TOK * 128) { const size_t t = idx >> 7; const int h = (idx >> 4) & 7, pc = idx & 15;
            l0[k] = lse2[(t * 3 + 0) * 8 + h]; l1[k] = lse2[(t * 3 + 1) * 8 + h]; l2[k] = lse2[(t * 3 + 2) * 8 + h];
            const bf16_t* p0 = proj + t * NP1 + h * 128 + pc * 8; w0[k] = *(const u32x4*)p0; w1[k] = *(const u32x4*)(p0 + 3072); w2[k] = *(const u32x4*)(p0 + 6144); } }
#pragma unroll
        for (int k = 0; k < 4; ++k) { const int idx = idx0 + k * nt; if (idx < T_TOK * 128) { const size_t t = idx >> 7; const int h = (idx >> 4) & 7, pc = idx & 15;
            const float m = fmaxf(l0[k], fmaxf(l1[k], l2[k])); float a0 = __builtin_amdgcn_exp2f(l0[k] - m), a1 = __builtin_amdgcn_exp2f(l1[k] - m), a2 = __builtin_amdgcn_exp2f(l2[k] - m);
            const float inv = 1.0f / (a0 + a1 + a2); a0 *= inv; a1 *= inv; a2 *= inv;
            const u32x4 x0 = w0[k], x1 = w1[k], x2 = w2[k]; u32x4 o;
            o.x = pk2(a0 * bflo(x0.x) + a1 * bflo(x1.x) + a2 * bflo(x2.x), a0 * bfhi(x0.x) + a1 * bfhi(x1.x) + a2 * bfhi(x2.x));
            o.y = pk2(a0 * bflo(x0.y) + a1 * bflo(x1.y) + a2 * bflo(x2.y), a0 * bfhi(x0.y) + a1 * bfhi(x1.y) + a2 * bfhi(x2.y));
            o.z = pk2(a0 * bflo(x0.z) + a1 * bflo(x1.z) + a2 * bflo(x2.z), a0 * bfhi(x0.z) + a1 * bfhi(x1.z) + a2 * bfhi(x2.z));
            o.w = pk2(a0 * bflo(x0.w) + a1 * bflo(x1.w) + a2 * bflo(x2.w), a0 * bfhi(x0.w) + a1 * bfhi(x1.w) + a2 * bfhi(x2.w));
            *(u32x4*)(proj + t * NP1 + h * 128 + pc * 8) = o; } }
    }
}

__device__ __forceinline__ float ret_l2g(int h) { return log2f(1.0f - exp2f(-5.0f - (float)h)); }
__device__ __forceinline__ void ret_kv(LAS unsigned char* lds, const bf16_t* proj, bf16_t* kvb) {
    const int tid = otid(), wid = __builtin_amdgcn_readfirstlane(tid >> 6), lane = tid & 63, fr = lane & 15, g4 = lane >> 4;
    LAS unsigned char* Kimg = lds; LAS unsigned char* Vimg = lds + 38912;
    u32x4 kr[4], vr[8];
#define RKV_LOAD(unit_) do { const int n_ = (unit_) & 63, h_ = ((unit_) >> 6) & 7, b_ = (unit_) >> 9; const size_t t0_ = (size_t)b_ * SEQ + 128 * n_; \
        _Pragma("unroll") for (int i = 0; i < 4; ++i) { const int q = tid + 512 * i, row = q >> 4, pc = q & 15; kr[i] = *(const u32x4*)(proj + (t0_ + row) * NP1 + RK0 + h_ * 128 + pc * 8); } \
        _Pragma("unroll") for (int i = 0; i < 8; ++i) { const int q = tid + 512 * i, row = q >> 5, pc = q & 31; vr[i] = *(const u32x4*)(proj + (t0_ + row) * NP1 + RV0 + h_ * 256 + pc * 8); } } while (0)
    int unit = blockIdx.x;
    if (unit < 1024) RKV_LOAD(unit);
    for (; unit < 1024; unit += gridDim.x) {
        const int h = (unit >> 6) & 7;
        const float l2g = ret_l2g(h);
        __syncthreads();
#pragma unroll
        for (int i = 0; i < 4; ++i) { const int q = tid + 512 * i, row = q >> 4, pc = q & 15;
            const u32x4 w = kr[i];
            const float d = __builtin_amdgcn_exp2f((float)(127 - row) * l2g);
            u32x4 o; o.x = pk2(bflo(w.x) * d, bfhi(w.x) * d); o.y = pk2(bflo(w.y) * d, bfhi(w.y) * d); o.z = pk2(bflo(w.z) * d, bfhi(w.z) * d); o.w = pk2(bflo(w.w) * d, bfhi(w.w) * d);
            *(LAS u32x4*)(Kimg + row * 304 + pc * 16) = o; }
#pragma unroll
        for (int i = 0; i < 8; ++i) { const int q = tid + 512 * i, row = q >> 5, pc = q & 31;
            *(LAS u32x4*)(Vimg + row * 560 + pc * 16) = vr[i]; }
        { const int un = unit + gridDim.x; if (un < 1024) RKV_LOAD(un); }
        asm volatile("s_waitcnt lgkmcnt(0)" ::: "memory"); __builtin_amdgcn_s_barrier(); asm volatile("" ::: "memory");
        f32x4 acc[16];
#pragma unroll
        for (int cc = 0; cc < 16; ++cc) acc[cc] = (f32x4){0.f, 0.f, 0.f, 0.f};
#pragma unroll
        for (int ks = 0; ks < 4; ++ks) {
            LAS unsigned char* ka = Kimg + (32 * ks + 8 * g4 + (fr >> 2)) * 304 + 32 * wid + 8 * (fr & 3);
            const bf16x8 a = tr2(ka, ka + 4 * 304);
#pragma unroll
            for (int cc = 0; cc < 16; ++cc) { LAS unsigned char* va = Vimg + (32 * ks + 8 * g4 + (fr >> 2)) * 560 + 32 * cc + 8 * (fr & 3);
                const bf16x8 bb = tr2(va, va + 4 * 560); acc[cc] = MFMA16(a, bb, acc[cc]); }
        }
        bf16_t* op = kvb + (size_t)unit * 32768 + 16 * wid + 8 * (g4 >> 1) + (size_t)(16 * (g4 & 1) + fr) * 128;
#pragma unroll
        for (int pr = 0; pr < 8; ++pr) { u32x2 wa, wb; wa.x = pk2(acc[2 * pr][0], acc[2 * pr][1]); wa.y = pk2(acc[2 * pr][2], acc[2 * pr][3]);
            wb.x = pk2(acc[2 * pr + 1][0], acc[2 * pr + 1][1]); wb.y = pk2(acc[2 * pr + 1][2], acc[2 * pr + 1][3]);
            *(u32x4*)(op + (size_t)(32 * pr) * 128) = widen16(wa, wb); }
    }
#undef RKV_LOAD
}
__device__ __forceinline__ void ret_scan(bf16_t* kvb) {
    const int gt = blockIdx.x * 512 + otid(), nt = gridDim.x * 512;
    for (int idx = gt; idx < 16 * 8192; idx += nt) { const int bh = idx >> 13, e4 = idx & 8191, h = bh & 7;
        const float cd = exp2f(128.0f * ret_l2g(h));
        bf16_t* base = kvb + (size_t)bh * 64 * 32768 + e4 * 4;
        float s0 = 0.f, s1 = 0.f, s2 = 0.f, s3 = 0.f;
        for (int n0 = 0; n0 < 64; n0 += 8) { u32x2 w[8];
#pragma unroll
            for (int i = 0; i < 8; ++i) w[i] = *(const u32x2*)(base + (size_t)(n0 + i) * 32768);
#pragma unroll
            for (int i = 0; i < 8; ++i) { u32x2 o; o.x = pk2(s0, s1); o.y = pk2(s2, s3); *(u32x2*)(base + (size_t)(n0 + i) * 32768) = o;
                s0 = cd * s0 + bflo(w[i].x); s1 = cd * s1 + bfhi(w[i].x); s2 = cd * s2 + bflo(w[i].y); s3 = cd * s3 + bfhi(w[i].y); } }
    }
}
__device__ __forceinline__ void ret_out(LAS unsigned char* lds, bf16_t* proj, const bf16_t* kvb) {
    const int tid = otid(), wid = __builtin_amdgcn_readfirstlane(tid >> 6), lane = tid & 63, fr = lane & 15, g4 = lane >> 4;
    LAS unsigned char* Kimg = lds; LAS unsigned char* Vimg = lds + 34816;
    for (int unit = blockIdx.x; unit < 1024; unit += gridDim.x) {
        const int n = unit & 63, h = (unit >> 6) & 7, b = unit >> 9;
        const size_t t0 = (size_t)b * SEQ + 128 * n; const float l2g = ret_l2g(h);
        __syncthreads();
        { u32x4 sr[8];
#pragma unroll
        for (int i = 0; i < 8; ++i) { const int q = tid + 512 * i, row = q >> 4, pc = q & 15; sr[i] = *(const u32x4*)(kvb + (size_t)unit * 32768 + row * 128 + pc * 8); }
#pragma unroll
        for (int i = 0; i < 8; ++i) { const int q = tid + 512 * i, row = q >> 4, pc = q & 15; *(LAS u32x4*)(lds + row * 272 + pc * 16) = sr[i]; } }
        const size_t tq = t0 + 16 * wid + fr; const int iq = 16 * wid + fr;
        bf16x8 qf[4];
#pragma unroll
        for (int kk = 0; kk < 4; ++kk) qf[kk] = *(const bf16x8*)(proj + tq * NP1 + RQ0 + h * 128 + 32 * kk + 8 * g4);
        __syncthreads();
        f32x4 acc[16];
        const float qd = __builtin_amdgcn_exp2f((float)(iq + 1) * l2g);
#pragma unroll
        for (int cc = 0; cc < 16; ++cc) { acc[cc] = (f32x4){0.f, 0.f, 0.f, 0.f};
#pragma unroll
            for (int kk = 0; kk < 4; ++kk) { const bf16x8 a = *(const LAS bf16x8*)(lds + (16 * cc + fr) * 272 + (32 * kk + 8 * g4) * 2); acc[cc] = MFMA16(a, qf[kk], acc[cc]); }
            acc[cc] *= qd; }
        __syncthreads();
        { u32x4 kr[4], vr[4];
#pragma unroll
        for (int i = 0; i < 4; ++i) { const int q = tid + 512 * i, row = q >> 4, pc = q & 15; kr[i] = *(const u32x4*)(proj + (t0 + row) * NP1 + RK0 + h * 128 + pc * 8); }
#pragma unroll
        for (int i = 0; i < 4; ++i) { const int q = tid + 512 * i, row = q >> 5, pc = q & 31; vr[i] = *(const u32x4*)(proj + (t0 + row) * NP1 + RV0 + h * 256 + pc * 8); }
#pragma unroll
        for (int i = 0; i < 4; ++i) { const int q = tid + 512 * i, row = q >> 4, pc = q & 15; *(LAS u32x4*)(Kimg + row * 272 + pc * 16) = kr[i]; }
#pragma unroll
        for (int i = 0; i < 4; ++i) { const int q = tid + 512 * i, row = q >> 5, pc = q & 31; *(LAS u32x4*)(Vimg + row * 544 + pc * 16) = vr[i]; }
#pragma unroll
        for (int i = 0; i < 4; ++i) { const int q = tid + 512 * (i + 4), row = q >> 5, pc = q & 31; kr[i] = *(const u32x4*)(proj + (t0 + row) * NP1 + RV0 + h * 256 + pc * 8); }
#pragma unroll
        for (int i = 0; i < 4; ++i) { const int q = tid + 512 * (i + 4), row = q >> 5, pc = q & 31; *(LAS u32x4*)(Vimg + row * 544 + pc * 16) = kr[i]; } }
        __syncthreads();
        const int ntile = (wid | 1) + 1;
        bf16x8 pf[4];
#pragma unroll
        for (int pp = 0; pp < 4; ++pp) {
            if (2 * pp < ntile) {
                f32x4 s0 = (f32x4){0.f, 0.f, 0.f, 0.f}, s1 = (f32x4){0.f, 0.f, 0.f, 0.f};
#pragma unroll
                for (int kk = 0; kk < 4; ++kk) { const bf16x8 a0 = *(const LAS bf16x8*)(Kimg + (32 * pp + fr) * 272 + (32 * kk + 8 * g4) * 2);
                    const bf16x8 a1 = *(const LAS bf16x8*)(Kimg + (32 * pp + 16 + fr) * 272 + (32 * kk + 8 * g4) * 2);
                    s0 = MFMA16(a0, qf[kk], s0); s1 = MFMA16(a1, qf[kk], s1); }
#pragma unroll
                for (int e = 0; e < 4; ++e) { const int j0 = 32 * pp + 4 * g4 + e, j1 = j0 + 16;
                    s0[e] = (iq >= j0) ? s0[e] * __builtin_amdgcn_exp2f((float)(iq - j0) * l2g) : 0.f;
                    s1[e] = (iq >= j1) ? s1[e] * __builtin_amdgcn_exp2f((float)(iq - j1) * l2g) : 0.f; }
                pf[pp] = __builtin_bit_cast(bf16x8, pk8(s0, s1));
            } else pf[pp] = (bf16x8){0, 0, 0, 0, 0, 0, 0, 0};
        }
#pragma unroll
        for (int pp = 0; pp < 4; ++pp) {
            if (2 * pp < ntile) {
#pragma unroll
                for (int cc = 0; cc < 16; ++cc) { LAS unsigned char* a0 = Vimg + (32 * pp + 4 * g4 + (fr >> 2)) * 544 + 32 * cc + 8 * (fr & 3);
                    const bf16x8 a = tr2(a0, a0 + 16 * 544); acc[cc] = MFMA16(a, pf[pp], acc[cc]); }
            }
        }
        bf16_t* gp = proj + tq * NP1 + RG0 + h * 256 + 4 * g4;
        u32x2 gwv[16];
#pragma unroll
        for (int cc = 0; cc < 16; ++cc) gwv[cc] = *(const u32x2*)(gp + 16 * cc);
        float sm = 0.f;
#pragma unroll
        for (int cc = 0; cc < 16; ++cc) sm += (acc[cc][0] + acc[cc][1]) + (acc[cc][2] + acc[cc][3]);
        sm += __shfl_xor(sm, 16); sm += __shfl_xor(sm, 32);
        const float mean = sm * (1.0f / 256.0f); float vq = 0.f;
#pragma unroll
        for (int cc = 0; cc < 16; ++cc) { const f32x4 d = acc[cc] - mean; vq += (d[0] * d[0] + d[1] * d[1]) + (d[2] * d[2] + d[3] * d[3]); }
        vq += __shfl_xor(vq, 16); vq += __shfl_xor(vq, 32);
        const float rstd = rsqrtf(vq * (1.0f / 256.0f) + 1e-5f);
#pragma unroll
        for (int cc = 0; cc < 16; ++cc) { const u32x2 gw = gwv[cc];
            u32x2 w; w.x = pk2((acc[cc][0] - mean) * rstd * bflo(gw.x), (acc[cc][1] - mean) * rstd * bfhi(gw.x));
            w.y = pk2((acc[cc][2] - mean) * rstd * bflo(gw.y), (acc[cc][3] - mean) * rstd * bfhi(gw.y));
            *(u32x2*)(gp + 16 * cc) = w; }
    }
}

__device__ __forceinline__ GD gd_plain(const bf16_t* A, int lda, const bf16_t* Bt, int ldb, int M, int N, int K) {
    GD d; d.type = 3; d.A = A; d.Bt = Bt; d.lda = lda; d.ldb = ldb; d.M = M; d.N = N; d.K = K; d.nb = 1; d.nh = 1;
    d.sAb = d.sAh = d.sBb = d.sBh = d.sOb = d.sOh = 0; d.O = nullptr; d.ldc = 0; d.base = nullptr; d.scale = 1.f; d.act = 0; d.split = 1 << 30; d.base0 = 0; d.base1 = 0;
    d.gate = nullptr; d.add = 0; d.cs = nullptr; d.ss = nullptr; d.hb = nullptr; d.ssout = nullptr; d.crot = 0; d.zrow = 0; d.wgm = 4; return d;
}
constexpr int NSTEPS = 41;
#ifndef WGM_SWIGLU
#define WGM_SWIGLU 8
#endif
#ifndef WGM_PROJ
#define WGM_PROJ 4
#endif
#ifndef WGM_GATES
#define WGM_GATES 4
#endif
#define SYNC_CASES case 2: case 3: case 6: case 8: case 13: case 15: case 18: case 24: case 25: case 29: case 31: case 32: case 33: case 38: case 39:
__device__ __forceinline__ bool sync_after(int st) {
    switch (st) { SYNC_CASES return true; default: return false; }
}

__global__ void __launch_bounds__(512) mega(Params p) {
    extern __shared__ __attribute__((aligned(16))) unsigned char lds_raw[];
    LAS unsigned char* lds = (LAS unsigned char*)lds_raw;
    cg::grid_group grid = cg::this_grid();
    unsigned char* ws = p.ws;
    const float* x = p.in[0]; const float* mem = p.in[1]; const int* pos = (const int*)p.in[2];
    float* hbuf = p.out;
    bf16_t* hb = (bf16_t*)(ws + R1);
    bf16_t* proj = (bf16_t*)(ws + R0);
    bf16_t* hid = (bf16_t*)(ws + R0);
    bf16_t* W1IN = (bf16_t*)(ws + R2); bf16_t* W1OUT = (bf16_t*)(ws + R0 + 256 * MIB);
    bf16_t* WMIX1 = (bf16_t*)(ws + R2); float* CS = (float*)(ws + R2 + 64 * MIB);
    bf16_t* KVB = (bf16_t*)(ws + R2); bf16_t* WG = (bf16_t*)(ws + R2 + 64 * MIB); bf16_t* WA = (bf16_t*)(ws + R2 + 80 * MIB); bf16_t* WR = (bf16_t*)(ws + R2 + 84 * MIB);
    float* LSE = (float*)(ws + R2 + 92 * MIB);
    bf16_t* WOUT = (bf16_t*)(ws + R2); bf16_t* WQC = (bf16_t*)(ws + R2 + 8 * MIB); bf16_t* M2T = (bf16_t*)(ws + R2 + 40 * MIB); bf16_t* VWT = (bf16_t*)(ws + R2 + 48 * MIB); bf16_t* WKV = (bf16_t*)(ws + R2 + 16 * MIB); bf16_t* WO = (bf16_t*)(ws + R2 + 32 * MIB);
    bf16_t* QX = (bf16_t*)(ws + R0); float* SC = (float*)(ws + R0 + 64 * MIB); bf16_t* PB = (bf16_t*)(ws + R0 + 128 * MIB); bf16_t* OX = (bf16_t*)(ws + R0 + 160 * MIB);
    bf16_t* MEMN = (bf16_t*)(ws + MEMN_OFF); bf16_t* KX = (bf16_t*)(ws + KX_OFF); bf16_t* VX = (bf16_t*)(ws + VT_OFF);
    bf16_t* W2IN = (bf16_t*)(ws + R0 + 256 * MIB); bf16_t* W2OUT = (bf16_t*)(ws + R0 + 256 * MIB + 46137344);
    unsigned* BAR = (unsigned*)(ws + CTL0);
    float* SS1 = (float*)(ws + CTL0 + CTL_BAR_BYTES); float* SS2 = SS1 + T_TOK; float* SS3 = SS2 + T_TOK; float* SS0 = (float*)(ws + SS0_OFF);
    volatile LAS unsigned* xst = (volatile LAS unsigned*)(lds + 143360);
    if (threadIdx.x < 4) xst[threadIdx.x] = 0u;
    __syncthreads();
    XcdBarrier xbar = xcd_barrier_post(BAR, xst);
    if (p.lo < 0) grid.sync();

    for (int st = p.lo; st < p.hi; ++st) {
        bool isg = false; GD d = gd_plain(nullptr, 0, nullptr, 0, 0, 0, 0);
        switch (st) {
        case 0: conv_job(lds, p.in[4], 2 * DFF, DM, W1IN, 2 * DFF, 1, 0, p.in[3]); break;
        case 1: conv_job(lds, p.in[5], DM, DFF, W1OUT, DM, 0, 0); break;
        case 2: norm_rows(x, nullptr, hb, T_TOK, SS0); break;
        case 3: d = gd_plain(hb, DM, W1IN, DM, T_TOK, 2 * DFF, DM); d.type = 0; d.O = hid; d.ldc = DFF; d.ss = SS0; d.wgm = WGM_SWIGLU; isg = true; break;
        case 4: d = gd_plain(hid, DFF, W1OUT, DFF, T_TOK, DM, DFF); d.type = 1; d.O = hbuf; d.ldc = DM; d.base = x; d.scale = 0.5f; d.hb = hb; d.ssout = SS1; isg = true; break;
        case 5: conv_job(lds, p.in[7], 19456, DM, WMIX1, NP1, 2, 0, p.in[6]); break;
        case 6: cs_table(pos, CS); break;
        case 8: d = gd_plain(hb, DM, WMIX1, DM, T_TOK, NP1, DM); d.type = 2; d.O = proj; d.ldc = NP1; d.cs = CS; d.ss = SS1; d.wgm = WGM_PROJ; isg = true; break;
        case 9: dil_attn(lds, proj, LSE); break;
        case 10: ret_kv(lds, proj, KVB); break;
        case 11: conv_job(lds, p.in[7], 19456, DM, WG, 4096, 0, NP1, p.in[6]); break;
        case 12: conv_job(lds, p.in[8], DM, 1024, WA, DM, 0, 0); break;
        case 13: conv_job(lds, p.in[9], DM, DM, WR, DM, 0, 0); break;
        case 14: ret_scan(KVB); break;
        case 15: dil_combine(proj, LSE); break;
        case 17: ret_out(lds, proj, KVB); break;
        case 18: d = gd_plain(hb, DM, WG, DM, T_TOK, 4096, DM); d.O = proj; d.ldc = NP1; d.act = 1; d.split = 8; d.base0 = GA0; d.base1 = GB0; d.ss = SS1; d.wgm = WGM_GATES; isg = true; break;
        case 19: d = gd_plain(proj, NP1, WA, 1024, T_TOK, DM, 1024); d.type = 4; d.O = proj + MG0; d.ldc = NP1; d.gate = proj + GA0; d.add = 0; isg = true; break;
        case 20: d = gd_plain(proj + RG0, NP1, WR, DM, T_TOK, DM, DM); d.type = 4; d.O = proj + MG0; d.ldc = NP1; d.gate = proj + GB0; d.add = 1; isg = true; break;
        case 21: conv_job(lds, p.in[10], DM, DM, WOUT, DM, 0, 0); break;
        case 22: cast_job(p.in[13], p.in[11], WQC, DM, DM); break;
        case 23: conv_job(lds, p.in[14], 2 * DM, DM, WKV, 2 * DM, 0, 0); break;
        case 24: conv_job(lds, p.in[15], DM, DM, WO, DM, 0, 0); norm_rows(mem, p.in[12], MEMN, 512); break;
        case 25: d = gd_plain(proj + MG0, NP1, WOUT, DM, T_TOK, DM, DM); d.type = 1; d.O = hbuf; d.ldc = DM; d.base = hbuf; d.scale = 1.f; d.hb = hb; d.ssout = SS2; isg = true; break;
        case 26: d = gd_plain(MEMN, DM, WKV, DM, 512, DM, DM); d.O = KX; d.ldc = DM; isg = true; break;
        case 27: d = gd_plain(MEMN, DM, WKV + (size_t)DM * DM, DM, 512, DM, DM); d.O = VX; d.ldc = DM; d.crot = 16; isg = true; break;
        case 28: conv_job(lds, p.in[17], 2 * DFF, DM, W2IN, 2 * DFF, 1, 0, p.in[16], 32, (int)gridDim.x - 32); break;
        case 29: conv_job(lds, p.in[18], DM, DFF, W2OUT, DM, 0, 0, nullptr, 32, (int)gridDim.x - 32); break;
        case 30: d = gd_plain(KX, DM, WQC, DM, 256, DM, 512); d.nb = 2; d.nh = 4; d.sAb = 256L * DM; d.sAh = 512; d.sBb = 0; d.sBh = 512;
                 d.O = M2T; d.ldc = DM; d.sOb = 4L * 256 * DM; d.sOh = 256L * DM; d.scale = 0.04419417382415922f * LOG2E; isg = true; break;
        case 31: d = gd_plain(WO, DM, VX, DM, DM, 256, 512); d.nb = 2; d.nh = 4; d.sAb = 0; d.sAh = 512; d.sBb = 256L * DM; d.sBh = 512;
                 d.O = VWT; d.ldc = 1024; d.sOb = (long)DM * 1024; d.sOh = 256; d.crot = 64; isg = true; break;
        case 32: d = gd_plain(hb, DM, M2T, DM, SEQ, 256, DM); d.type = 5; d.nb = 2; d.nh = 4; d.sAb = (long)SEQ * DM; d.sAh = 0; d.sBb = 4L * 256 * DM; d.sBh = 256L * DM;
                 d.O = PB; d.ldc = 1024; d.sOb = (long)SEQ * 1024; d.sOh = 256; d.ss = SS2; d.zrow = SEQ; isg = true; break;
        case 33: d = gd_plain(PB, 1024, VWT, 1024, SEQ, DM, 1024); d.type = 1; d.nb = 2; d.nh = 1; d.sAb = (long)SEQ * 1024; d.sBb = (long)DM * 1024;
                 d.O = hbuf; d.ldc = DM; d.sOb = (long)SEQ * DM; d.base = hbuf; d.scale = 1.f; d.hb = hb; d.ssout = SS3; d.zrow = SEQ; isg = true; break;
        case 38: d = gd_plain(hb, DM, W2IN, DM, T_TOK, 2 * DFF, DM); d.type = 0; d.O = hid; d.ldc = DFF; d.ss = SS3; d.wgm = WGM_SWIGLU; isg = true; break;
        case 39: d = gd_plain(hid, DFF, W2OUT, DFF, T_TOK, DM, DFF); d.type = 1; d.O = hbuf; d.ldc = DM; d.base = hbuf; d.scale = 0.5f; isg = true; break;
        case 40: final_norm(hbuf, p.in[19], T_TOK); break;
        default: break;
        }
        if (isg) {
            __syncthreads();
            pg8::Gemm g{d.A, d.Bt, d.K, d.lda, d.ldb};
            pg8::Sched S; S.nM = d.M / 256; S.nN = d.N / 256; S.per = S.nM * S.nN; S.total = S.per * d.nb * d.nh; S.G = gridDim.x; S.c = (int)((blockIdx.x + gridDim.x - d.crot) % gridDim.x); S.nh = d.nh; S.WGM = d.wgm; S.mnig = (unsigned)(0x100000000ull / (unsigned)(d.wgm * (d.N / 256))) + 1u;
            S.tA = 256L * d.lda * 2; S.tB = 256L * d.ldb * 2; S.sAb = d.sAb * 2; S.sAh = d.sAh * 2; S.sBb = d.sBb * 2; S.sBh = d.sBh * 2;
            switch (d.type) {
            case 0: { EpiSwiglu E{(bf16_t*)d.O, d.ldc, d.ss}; pg8::gemm_phase(lds, g, S, E); } break;
            case 1: { EpiF32 E{(float*)d.O, d.ldc, d.base, d.scale, d.sOb, d.sOh, d.hb, d.ssout, d.zrow}; pg8::gemm_phase(lds, g, S, E); } break;
            case 2: { EpiProj E{(bf16_t*)d.O, d.ldc, d.cs, d.ss}; pg8::gemm_phase(lds, g, S, E); } break;
            case 3: { EpiAct E{(bf16_t*)d.O, d.ldc, d.scale, d.act, d.split, d.base0, d.base1, d.sOb, d.sOh, d.ss}; pg8::gemm_phase(lds, g, S, E); } break;
            case 5: { EpiSoftmax E{(bf16_t*)d.O, d.ldc, d.sOb, d.sOh, (LAS float*)(lds + 131072), d.ss, d.zrow}; pg8::gemm_phase(lds, g, S, E); } break;
            default: { EpiGate E{(bf16_t*)d.O, d.ldc, d.gate, d.add}; pg8::gemm_phase(lds, g, S, E); } break;
            }
            __syncthreads();
        }
        if (st + 1 < p.hi && sync_after(st)) xcd_barrier(xbar);
    }
}

extern "C" void kernel_launch(void* const* d_in, const int* in_sizes, int n_in, void* d_out, int out_size, void* d_ws, size_t ws_size, hipStream_t stream) {
    static int grid_blocks = 0;
    if (!grid_blocks) {
        if (n_in != 20 || ws_size < (size_t)WS_NEED) { fprintf(stderr, "kernel_launch: unexpected inputs (n_in %d, ws %zu need %ld)\n", n_in, ws_size, (long)WS_NEED); grid_blocks = -1; return; }
        int dev = 0, cus = 0, per_cu = 0;
        (void)hipGetDevice(&dev);
        (void)hipDeviceGetAttribute(&cus, hipDeviceAttributeMultiprocessorCount, dev);
        if (hipFuncSetAttribute((const void*)mega, hipFuncAttributeMaxDynamicSharedMemorySize, LDS_BYTES) != hipSuccess) { fprintf(stderr, "hipFuncSetAttribute failed\n"); grid_blocks = -1; return; }
        (void)hipOccupancyMaxActiveBlocksPerMultiprocessor(&per_cu, (const void*)mega, 512, LDS_BYTES);
        if (per_cu < 1) { fprintf(stderr, "occupancy query gave %d\n", per_cu); per_cu = 1; }
        grid_blocks = cus * 1;
    }
    if (grid_blocks < 0) return;
    (void)hipMemsetAsync((char*)d_ws + CTL0, 0, CTL_BYTES, stream);
    Params p{};
    for (int i = 0; i < 20; ++i) p.in[i] = (const float*)d_in[i];
    p.out = (float*)d_out; p.ws = (unsigned char*)d_ws;
#if ONE_LAUNCH
    p.lo = 0; p.hi = NSTEPS;
    void* args[] = {&p};
    hipError_t e = hipLaunchCooperativeKernel((const void*)mega, dim3(grid_blocks), dim3(512), args, LDS_BYTES, stream);
    if (e != hipSuccess) fprintf(stderr, "cooperative launch failed: %s (grid %d)\n", hipGetErrorString(e), grid_blocks);
#else
    int lo = 0;
    for (int st = 0; st < NSTEPS; ++st) {
        bool cut = (st == NSTEPS - 1);
        switch (st) { SYNC_CASES cut = true; break; default: break; }
        if (cut) { p.lo = lo; p.hi = st + 1; hipLaunchKernelGGL(mega, dim3(grid_blocks), dim3(512), LDS_BYTES, stream, p); lo = st + 1; }
    }
#endif
}
```
